# Optimizing an MI355X kernel written in HIP

```python
import jax, jax.numpy as jnp
from jax import lax
import numpy as np

D_MODEL = 1024
BATCH = 16
SEQ = 2048
DEPTH = 2

HEAD_DIM = 64
FOX_HEADS = D_MODEL // HEAD_DIM
SWA_Q_HEADS = D_MODEL // HEAD_DIM
SWA_KV_HEADS = max(1, SWA_Q_HEADS // 8)
SWA_GROUP = SWA_Q_HEADS // SWA_KV_HEADS
WINDOW = 128
Q_BLOCK = 128
D_FF = ((8 * D_MODEL // 3 + 127) // 128) * 128
N_MIXERS = 2
RMS_EPS = 1e-6
NEG_INF = -1e30

kernel_name = "fox_swa_sink_alibi_macaron_hybrid"


def rmsnorm(x, g):
    xf = x.astype(jnp.float32)
    y = xf * lax.rsqrt(jnp.mean(xf * xf, axis=-1, keepdims=True) + RMS_EPS)
    return (y * g.astype(jnp.float32)).astype(x.dtype)


def swiglu(h, w_gate, w_up, w_down):
    return (jax.nn.silu(h @ w_gate) * (h @ w_up)) @ w_down


def alibi_slopes(n_heads):
    return jnp.asarray(2.0 ** (-8.0 * np.arange(1, n_heads + 1) / n_heads), dtype=jnp.float32)


def fox_mixer(h, w_in, b_forget, w_out):
    B, S, D = h.shape
    H, hd = FOX_HEADS, HEAD_DIM
    proj = h @ w_in
    q, k, v, f_logit = jnp.split(proj, [H * hd, 2 * H * hd, 3 * H * hd], axis=-1)
    q = q.reshape(B, S, H, hd)
    k = k.reshape(B, S, H, hd)
    v = v.reshape(B, S, H, hd)
    log_f = jax.nn.log_sigmoid((f_logit + b_forget).astype(jnp.float32))
    c = jnp.cumsum(log_f, axis=1).transpose(0, 2, 1)
    scale = hd ** -0.5
    n_blocks = S // Q_BLOCK
    outs = []
    for i in range(n_blocks):
        q0, q1 = i * Q_BLOCK, (i + 1) * Q_BLOCK
        qb, kb, vb = q[:, q0:q1], k[:, :q1], v[:, :q1]
        s = jnp.einsum('bqhd,bkhd->bhqk', qb, kb).astype(jnp.float32) * scale
        s = s + (c[:, :, q0:q1, None] - c[:, :, None, :q1])
        causal = (q0 + jnp.arange(Q_BLOCK))[:, None] >= jnp.arange(q1)[None, :]
        s = jnp.where(causal, s, NEG_INF)
        p = jax.nn.softmax(s, axis=-1).astype(vb.dtype)
        outs.append(jnp.einsum('bhqk,bkhd->bqhd', p, vb))
    o = jnp.concatenate(outs, axis=1).reshape(B, S, H * hd)
    return o @ w_out


def swa_sink_mixer(h, w_in, sinks, w_out):
    B, S, D = h.shape
    Hq, Hkv, G, hd, W = SWA_Q_HEADS, SWA_KV_HEADS, SWA_GROUP, HEAD_DIM, WINDOW
    proj = h @ w_in
    q, k, v = jnp.split(proj, [Hq * hd, Hq * hd + Hkv * hd], axis=-1)
    nb = S // W
    q = q.reshape(B, nb, W, Hkv, G, hd)
    k = k.reshape(B, nb, W, Hkv, hd)
    v = v.reshape(B, nb, W, Hkv, hd)
    pad = jnp.zeros_like(k[:, :1])
    k_band = jnp.concatenate([jnp.concatenate([pad, k[:, :-1]], axis=1), k], axis=2)
    v_band = jnp.concatenate([jnp.concatenate([pad, v[:, :-1]], axis=1), v], axis=2)
    s = jnp.einsum('bnqkgd,bnskd->bnkgqs', q, k_band).astype(jnp.float32) * (hd ** -0.5)
    qi = jnp.arange(W)[:, None]
    kj = jnp.arange(2 * W)[None, :]
    dist = qi + W - kj
    valid = (dist >= 0) & (dist < W)
    blk = jnp.arange(nb)[:, None, None]
    valid = valid[None] & ((blk > 0) | (kj[None] >= W))
    slopes = alibi_slopes(Hq).reshape(Hkv, G)
    s = s - slopes[:, :, None, None] * dist.astype(jnp.float32)[None, None]
    s = jnp.where(valid[None, :, None, None], s, NEG_INF)
    sink = jnp.broadcast_to(sinks.astype(jnp.float32).reshape(1, 1, Hkv, G, 1, 1), s.shape[:-1] + (1,))
    p = jax.nn.softmax(jnp.concatenate([s, sink], axis=-1), axis=-1)[..., :-1]
    o = jnp.einsum('bnkgqs,bnskd->bnqkgd', p.astype(v_band.dtype), v_band).reshape(B, S, Hq * hd)
    return o @ w_out


def setup_inputs(seed: int = 0) -> dict:
    key = jax.random.key(seed)
    ks = iter(jax.random.split(key, 64))
    f32 = jnp.float32

    def nrm(shape, scale):
        return jax.random.normal(next(ks), shape, f32) * scale

    def gain():
        return 1.0 + nrm((D_MODEL,), 0.01)

    def ffn():
        return (gain(), nrm((D_MODEL, D_FF), D_MODEL ** -0.5), nrm((D_MODEL, D_FF), D_MODEL ** -0.5),
                nrm((D_FF, D_MODEL), D_FF ** -0.5))

    inp = {"x": nrm((BATCH, SEQ, D_MODEL), 1.0)}
    g, wg, wu, wd = ffn()
    inp.update(l0_ffn1_norm=g, l0_ffn1_w_gate=wg, l0_ffn1_w_up=wu, l0_ffn1_w_down=wd)
    inp["l0_mix_norm"] = gain()
    w_qkv = nrm((D_MODEL, 3 * FOX_HEADS * HEAD_DIM), D_MODEL ** -0.5)
    w_f = nrm((D_MODEL, FOX_HEADS), 0.1 * D_MODEL ** -0.5)
    inp["l0_fox_w_in"] = jnp.concatenate([w_qkv, w_f], axis=1)
    inp["l0_fox_b_forget"] = 3.0 + nrm((FOX_HEADS,), 0.5)
    inp["l0_fox_w_out"] = nrm((FOX_HEADS * HEAD_DIM, D_MODEL), (FOX_HEADS * HEAD_DIM) ** -0.5)
    g, wg, wu, wd = ffn()
    inp.update(l0_ffn2_norm=g, l0_ffn2_w_gate=wg, l0_ffn2_w_up=wu, l0_ffn2_w_down=wd)
    g, wg, wu, wd = ffn()
    inp.update(l1_ffn1_norm=g, l1_ffn1_w_gate=wg, l1_ffn1_w_up=wu, l1_ffn1_w_down=wd)
    inp["l1_mix_norm"] = gain()
    inp["l1_swa_w_in"] = nrm((D_MODEL, (SWA_Q_HEADS + 2 * SWA_KV_HEADS) * HEAD_DIM), D_MODEL ** -0.5)
    inp["l1_swa_sinks"] = nrm((SWA_Q_HEADS,), 0.5)
    inp["l1_swa_w_out"] = nrm((SWA_Q_HEADS * HEAD_DIM, D_MODEL), (SWA_Q_HEADS * HEAD_DIM) ** -0.5)
    g, wg, wu, wd = ffn()
    inp.update(l1_ffn2_norm=g, l1_ffn2_w_gate=wg, l1_ffn2_w_up=wu, l1_ffn2_w_down=wd)
    inp["final_norm"] = gain()
    return inp


def reference(x,
              l0_ffn1_norm, l0_ffn1_w_gate, l0_ffn1_w_up, l0_ffn1_w_down,
              l0_mix_norm, l0_fox_w_in, l0_fox_b_forget, l0_fox_w_out,
              l0_ffn2_norm, l0_ffn2_w_gate, l0_ffn2_w_up, l0_ffn2_w_down,
              l1_ffn1_norm, l1_ffn1_w_gate, l1_ffn1_w_up, l1_ffn1_w_down,
              l1_mix_norm, l1_swa_w_in, l1_swa_sinks, l1_swa_w_out,
              l1_ffn2_norm, l1_ffn2_w_gate, l1_ffn2_w_up, l1_ffn2_w_down,
              final_norm):
    layers = [
        ((l0_ffn1_norm, l0_ffn1_w_gate, l0_ffn1_w_up, l0_ffn1_w_down),
         (l0_mix_norm, l0_fox_w_in, l0_fox_b_forget, l0_fox_w_out),
         (l0_ffn2_norm, l0_ffn2_w_gate, l0_ffn2_w_up, l0_ffn2_w_down)),
        ((l1_ffn1_norm, l1_ffn1_w_gate, l1_ffn1_w_up, l1_ffn1_w_down),
         (l1_mix_norm, l1_swa_w_in, l1_swa_sinks, l1_swa_w_out),
         (l1_ffn2_norm, l1_ffn2_w_gate, l1_ffn2_w_up, l1_ffn2_w_down)),
    ]
    mixers = (fox_mixer, swa_sink_mixer)
    h = x
    for i in range(DEPTH):
        ffn1, mix, ffn2 = layers[i]
        h = h + 0.5 * swiglu(rmsnorm(h, ffn1[0]), *ffn1[1:])
        h = h + mixers[i % N_MIXERS](rmsnorm(h, mix[0]), *mix[1:])
        h = h + 0.5 * swiglu(rmsnorm(h, ffn2[0]), *ffn2[1:])
    return rmsnorm(h, final_norm)
```

```cpp
#include <hip/hip_runtime.h>
#include <hip/hip_cooperative_groups.h>
#include <cstdio>
#include <cstdint>
#include <cmath>
namespace cg = cooperative_groups;
namespace pg8 {
#define PG8_LAS __attribute__((address_space(3)))
typedef unsigned short bf16_t;
typedef short bf16x8 __attribute__((ext_vector_type(8)));
typedef float f32x4 __attribute__((ext_vector_type(4)));
typedef unsigned u32x4 __attribute__((ext_vector_type(4)));
constexpr int BM = 256, BK = 64, HALF = 128, HTB = HALF * BK * 2  , STAGE_BYTES = 8 * HTB, NXCD = 8, WGM = 8;

__host__ __device__ __forceinline__ int lds_byte(int r, int c) { const int st = (r >> 4) * 2 + (c >> 5), rr = r & 15, cc = c & 31, ob = rr * 64 + cc * 2; return st * 1024 + (ob ^ (((ob >> 9) & 1) << 5)); }
__host__ __device__ __forceinline__ void stage_rc(int b, int& R, int& C) { const int st = b / 1024, sb = b % 1024, swz = sb ^ (((sb >> 9) & 1) << 5); R = (st >> 1) * 16 + swz / 64; C = (st & 1) * 32 + (swz % 64) / 2; }
__host__ __device__ __forceinline__ int perm32(int rho) { const int n = rho >> 4, i = rho & 15; return 8 * (i >> 2) + 4 * n + (i & 3); }

struct Unit { int pm, pn; };
struct Gemm { const bf16_t* A; const bf16_t* Bt; int M, N, K; };

struct StaticOrder {
    int nM, nN, nwg, G, c;
    __host__ __device__ void init(int M, int N, int G_, int c_) { nM = M / BM; nN = N / BM; nwg = nM * nN; G = G_; c = c_; }
    __host__ __device__ bool next(int i, Unit& u) const {
        const long L = (long)i * G + c; if (L >= nwg) return false;
        int wgid = (int)L; { const int q = nwg / NXCD, r = nwg % NXCD, xcd = wgid % NXCD, off = wgid / NXCD; wgid = (xcd < r ? xcd * (q + 1) : r * (q + 1) + (xcd - r) * q) + off; }
        const int nig = WGM * nN, gid = wgid / nig, fm = gid * WGM, gsz = (nM - fm) < WGM ? (nM - fm) : WGM;
        u.pm = fm + ((wgid % nig) % gsz); u.pn = (wgid % nig) / gsz; return true;
    }
    __device__ __forceinline__ void a_ready(const Unit&) const {}
    __device__ __forceinline__ void done(const Unit&) const {}
};

__device__ __forceinline__ unsigned cvt_pk_bf16(float lo, float hi) { unsigned r; asm volatile("v_cvt_pk_bf16_f32 %0, %1, %2" : "=v"(r) : "v"(lo), "v"(hi)); return r; }
typedef float f32x2 __attribute__((ext_vector_type(2)));
typedef unsigned u32x2 __attribute__((ext_vector_type(2)));
typedef unsigned long long rss_t;
__device__ __forceinline__ float ld_agent(const rss_t* p) { return (float)__hip_atomic_load(p, __ATOMIC_RELAXED, __HIP_MEMORY_SCOPE_AGENT) * (1.0f / 16777216.0f); }
__device__ __forceinline__ rss_t rss_fix(float ss) { return (rss_t)(ss * 16777216.0f); }
__device__ __forceinline__ float rstd_of(const rss_t* rowss, int row) { return __builtin_amdgcn_rsqf(ld_agent(rowss + row) * (1.0f / 1024.0f) + 1e-6f); }
__device__ __forceinline__ unsigned silu_pk(f32x2 g, f32x2 u, float k1, float k2) {
    const f32x2 t = g * k1; f32x2 ex; ex.x = __builtin_amdgcn_exp2f(t.x); ex.y = __builtin_amdgcn_exp2f(t.y);
    const f32x2 d = ex + 1.0f; f32x2 r; r.x = __builtin_amdgcn_rcpf(d.x); r.y = __builtin_amdgcn_rcpf(d.y);
    const f32x2 o = (g * u) * (r * k2);
    return cvt_pk_bf16(o.x, o.y);
}
__device__ __forceinline__ float silu_mul(float g, float u) { return g * __builtin_amdgcn_rcpf(1.0f + __builtin_amdgcn_exp2f(-1.4426950408889634f * g)) * u; }

struct EpiSwiglu {
    static constexpr bool PERM = true, AFTER_DRAIN = false, PREFETCH = false;
    bf16_t* O; int ldc; const rss_t* rowss;
    __device__ __forceinline__ void operator()(const f32x4 (&acc)[2][2][4][2], const Unit& u, int wr, int wc, int fr, int fq) const {
        const int row0 = u.pm * BM + wr * 64 + fr, col0 = u.pn * HALF + wc * 32 + 8 * fq;
        float ssq[2][4];
#pragma unroll
        for (int ai = 0; ai < 2; ++ai)
#pragma unroll
            for (int m = 0; m < 4; ++m) ssq[ai][m] = ld_agent(rowss + row0 + ai * HALF + m * 16);
#pragma unroll
        for (int ai = 0; ai < 2; ++ai)
#pragma unroll
            for (int m = 0; m < 4; ++m) {
                const int row = row0 + ai * HALF + m * 16; const float rs = __builtin_amdgcn_rsqf(ssq[ai][m] * (1.0f / 1024.0f) + 1e-6f);
                const float k1 = -1.4426950408889634f * rs, k2 = rs * rs;
                u32x4 w;
#pragma unroll
                for (int n = 0; n < 2; ++n) {
                    const f32x4 gv = acc[ai][0][m][n], uv = acc[ai][1][m][n];
                    const unsigned lo = silu_pk((f32x2){gv[0], gv[1]}, (f32x2){uv[0], uv[1]}, k1, k2), hi = silu_pk((f32x2){gv[2], gv[3]}, (f32x2){uv[2], uv[3]}, k1, k2);
                    if (n == 0) { w.x = lo; w.y = hi; } else { w.z = lo; w.w = hi; }
                }
                *(u32x4*)(O + (size_t)row * ldc + col0) = w;
            }
    }
};
struct EpiScale {
    static constexpr bool PERM = true, AFTER_DRAIN = false, PREFETCH = false;
    bf16_t* O; int ldc; const rss_t* rowss; int split_cols; size_t split_stride; int qtiles; float qscale;
    __device__ __forceinline__ void operator()(const f32x4 (&acc)[2][2][4][2], const Unit& u, int wr, int wc, int fr, int fq) const {
        const int row0 = u.pm * BM + wr * 64 + fr; int colt = u.pn * BM; bf16_t* base = O;
        if (split_cols) { const int t = colt / split_cols; base += (size_t)t * split_stride; colt -= t * split_cols; }
        const float sc = (u.pn < qtiles) ? qscale : 1.0f;
        const int col0 = colt + wc * 32 + 8 * fq;
        float ssq[2][4];
#pragma unroll
        for (int ai = 0; ai < 2; ++ai)
#pragma unroll
            for (int m = 0; m < 4; ++m) ssq[ai][m] = ld_agent(rowss + row0 + ai * HALF + m * 16);
#pragma unroll
        for (int ai = 0; ai < 2; ++ai)
#pragma unroll
            for (int m = 0; m < 4; ++m) {
                const int row = row0 + ai * HALF + m * 16; const float rs = __builtin_amdgcn_rsqf(ssq[ai][m] * (1.0f / 1024.0f) + 1e-6f) * sc;
                bf16_t* rowp = base + (size_t)row * ldc + col0;
#pragma unroll
                for (int bj = 0; bj < 2; ++bj) { const f32x4 v0 = acc[ai][bj][m][0] * rs, v1 = acc[ai][bj][m][1] * rs;
                    u32x4 w; w.x = cvt_pk_bf16(v0[0], v0[1]); w.y = cvt_pk_bf16(v0[2], v0[3]); w.z = cvt_pk_bf16(v1[0], v1[1]); w.w = cvt_pk_bf16(v1[2], v1[3]);
                    *(u32x4*)(rowp + bj * HALF) = w; }
            }
    }
};
struct EpiResid {
    static constexpr bool PERM = true, AFTER_DRAIN = false, PREFETCH = false;
    const float* base32; const bf16_t* base16; float* out32; bf16_t* hb; rss_t* rowss_next; float alpha;
    __device__ __forceinline__ void operator()(const f32x4 (&acc)[2][2][4][2], const Unit& u, int wr, int wc, int fr, int fq) const {
        const int row0 = u.pm * BM + wr * 64 + fr, col0 = u.pn * BM + wc * 32 + 8 * fq;
        if (base32) {
            f32x4 pre[4][4];
#pragma unroll
            for (int m = 0; m < 4; ++m) { const size_t off = (size_t)(row0 + m * 16) * 1024 + col0;
#pragma unroll
                for (int bj = 0; bj < 2; ++bj) { pre[m][2 * bj] = *(const f32x4*)(base32 + off + bj * HALF); pre[m][2 * bj + 1] = *(const f32x4*)(base32 + off + bj * HALF + 4); } }
            asm volatile("" ::: "memory");
#pragma unroll
            for (int ai = 0; ai < 2; ++ai)
#pragma unroll
                for (int m = 0; m < 4; ++m) {
                    const int row = row0 + ai * HALF + m * 16; const size_t off = (size_t)row * 1024 + col0; float ss = 0.f;
#pragma unroll
                    for (int bj = 0; bj < 2; ++bj) {
                        const f32x4 v0 = pre[m][2 * bj] + acc[ai][bj][m][0] * alpha, v1 = pre[m][2 * bj + 1] + acc[ai][bj][m][1] * alpha;
                        store(off + bj * HALF, v0, v1, ss);
                    }
                    if (ai == 0) { const size_t off2 = off + (size_t)HALF * 1024;
#pragma unroll
                        for (int bj = 0; bj < 2; ++bj) { pre[m][2 * bj] = *(const f32x4*)(base32 + off2 + bj * HALF); pre[m][2 * bj + 1] = *(const f32x4*)(base32 + off2 + bj * HALF + 4); } }
                    rowsum(row, ss, fq);
                    asm volatile("" ::: "memory");
                }
        } else {
            u32x4 pre[2][4][2];
#pragma unroll
            for (int ai = 0; ai < 2; ++ai)
#pragma unroll
                for (int m = 0; m < 4; ++m) { const size_t off = (size_t)(row0 + ai * HALF + m * 16) * 1024 + col0;
#pragma unroll
                    for (int bj = 0; bj < 2; ++bj) pre[ai][m][bj] = *(const u32x4*)(base16 + off + bj * HALF); }
            asm volatile("" ::: "memory");
#pragma unroll
            for (int ai = 0; ai < 2; ++ai)
#pragma unroll
                for (int m = 0; m < 4; ++m) {
                    const int row = row0 + ai * HALF + m * 16; const size_t off = (size_t)row * 1024 + col0; float ss = 0.f;
#pragma unroll
                    for (int bj = 0; bj < 2; ++bj) { const u32x4 p = pre[ai][m][bj];
                        const f32x4 b0 = {__uint_as_float(p.x << 16), __uint_as_float(p.x & 0xffff0000u), __uint_as_float(p.y << 16), __uint_as_float(p.y & 0xffff0000u)};
                        const f32x4 b1 = {__uint_as_float(p.z << 16), __uint_as_float(p.z & 0xffff0000u), __uint_as_float(p.w << 16), __uint_as_float(p.w & 0xffff0000u)};
                        const f32x4 v0 = b0 + acc[ai][bj][m][0] * alpha, v1 = b1 + acc[ai][bj][m][1] * alpha;
                        store(off + bj * HALF, v0, v1, ss);
                    }
                    rowsum(row, ss, fq);
                    if (m & 1) asm volatile("" ::: "memory");
                }
        }
    }
    __device__ __forceinline__ void store(size_t o, const f32x4& v0, const f32x4& v1, float& ss) const {
        if (out32) { *(f32x4*)(out32 + o) = v0; *(f32x4*)(out32 + o + 4) = v1; }
        ss += (v0[0] * v0[0] + v0[1] * v0[1]) + (v0[2] * v0[2] + v0[3] * v0[3]) + (v1[0] * v1[0] + v1[1] * v1[1]) + (v1[2] * v1[2] + v1[3] * v1[3]);
        if (hb) { u32x4 w; w.x = cvt_pk_bf16(v0[0], v0[1]); w.y = cvt_pk_bf16(v0[2], v0[3]); w.z = cvt_pk_bf16(v1[0], v1[1]); w.w = cvt_pk_bf16(v1[2], v1[3]); *(u32x4*)(hb + o) = w; }
    }
    __device__ __forceinline__ void rowsum(int row, float ss, int fq) const {
        if (rowss_next) { ss += __shfl_xor(ss, 16); ss += __shfl_xor(ss, 32);
            if (fq == 0) (void)__hip_atomic_fetch_add(rowss_next + row, rss_fix(ss), __ATOMIC_RELAXED, __HIP_MEMORY_SCOPE_AGENT); }
    }
};
template <class Epi, class Sched, bool ALIGN_EPI = false, bool SP2 = false>
__device__ __forceinline__ void gemm_phase(PG8_LAS unsigned char* lds, const Gemm g, const Sched& S, const Epi& E) {
    const int tid = threadIdx.x, wid = __builtin_amdgcn_readfirstlane(tid >> 6), lane = tid & 63, wr = wid >> 2, wc = wid & 3, fr = lane & 15, fq = lane >> 4;
    const int K = g.K, nt = K / BK;
    unsigned voffA[2], voffB[2];
#pragma unroll
    for (int i = 0; i < 2; ++i) { int R, C; stage_rc(tid * 16 + i * 8192, R, C); const int Rb = Epi::PERM ? ((R & ~31) + perm32(R & 31)) : R;
        voffA[i] = (unsigned)(R * K + C) * 2u; voffB[i] = (unsigned)(Rb * K + C) * 2u; }
    const size_t kstep = (size_t)(BK * 2);
    const size_t hstep = (size_t)HALF * K * 2;
    const size_t tstep = 2 * hstep;
    const unsigned ldsw = (unsigned)wid * 1024u;
    const int aoff = lds_byte(wr * 64 + fr, fq * 8), boff = lds_byte(wc * 32 + fr, fq * 8);
#define PG8_SA(b, h) (((b) * 2 + (h)) * HTB)
#define PG8_SB(b, h) ((4 + (b) * 2 + (h)) * HTB)
#define PG8_STAGE(bufoff, gbase, voff) do { _Pragma("unroll") for (int _i = 0; _i < 2; ++_i) \
        __builtin_amdgcn_global_load_lds((const unsigned*)((const char*)(gbase) + (voff)[_i]), (PG8_LAS unsigned*)(lds + (bufoff) + ldsw + _i * 8192), 16, 0, 0); } while (0)
#define PG8_LDA(dst, b, h) do { _Pragma("unroll") for (int m = 0; m < 4; ++m) _Pragma("unroll") for (int k = 0; k < 2; ++k) dst[m][k] = *(const PG8_LAS bf16x8*)(lds + PG8_SA(b, h) + aoff + m * 2048 + k * 1024); } while (0)
#define PG8_LDB(dst, b, h) do { _Pragma("unroll") for (int n = 0; n < 2; ++n) _Pragma("unroll") for (int k = 0; k < 2; ++k) dst[n][k] = *(const PG8_LAS bf16x8*)(lds + PG8_SB(b, h) + boff + n * 2048 + k * 1024); } while (0)
#define PG8_MMA(ai, bj, At, Bt) do { __builtin_amdgcn_s_setprio(1); _Pragma("unroll") for (int m = 0; m < 4; ++m) _Pragma("unroll") for (int n = 0; n < 2; ++n) _Pragma("unroll") for (int k = 0; k < 2; ++k) \
        acc[ai][bj][m][n] = __builtin_amdgcn_mfma_f32_16x16x32_bf16(Bt[n][k], At[m][k], acc[ai][bj][m][n], 0, 0, 0); __builtin_amdgcn_s_setprio(0); } while (0)
#define PG8_WAIT_V(n) asm volatile("s_waitcnt vmcnt(" #n ")" ::: "memory")
#define PG8_WAIT_L(n) asm volatile("s_waitcnt lgkmcnt(" #n ")" ::: "memory")
#define PG8_BAR __builtin_amdgcn_s_barrier()
#define PG8_SCHED __builtin_amdgcn_sched_barrier(0)
    Unit cur, nxt; int ui = 0;
    if (!S.next(0, cur)) return;
    f32x4 acc[2][2][4][2];
#pragma unroll
    for (int a = 0; a < 2; ++a)
#pragma unroll
        for (int b = 0; b < 2; ++b)
#pragma unroll
            for (int m = 0; m < 4; ++m)
#pragma unroll
                for (int n = 0; n < 2; ++n) acc[a][b][m][n] = (f32x4){0.f, 0.f, 0.f, 0.f};
    bf16x8 At[4][2], B0[2][2], B1[2][2];
    const char* cA = (const char*)g.A + (size_t)cur.pm * tstep; const char* cB = (const char*)g.Bt + (size_t)cur.pn * tstep;
    S.a_ready(cur);
    if constexpr (SP2) {
        PG8_STAGE(PG8_SB(0, 0), cB, voffB); PG8_STAGE(PG8_SB(0, 1), cB + hstep, voffB); PG8_STAGE(PG8_SA(0, 0), cA, voffA); PG8_STAGE(PG8_SA(0, 1), cA + hstep, voffA);
        if (wr == 1) PG8_BAR;
        PG8_WAIT_V(2); PG8_BAR;
        PG8_STAGE(PG8_SB(1, 0), cB + kstep, voffB); PG8_STAGE(PG8_SA(1, 0), cA + kstep, voffA); PG8_STAGE(PG8_SB(1, 1), cB + hstep + kstep, voffB);
        PG8_WAIT_V(6); PG8_BAR;
    } else {
        PG8_STAGE(PG8_SB(0, 0), cB, voffB); PG8_STAGE(PG8_SA(0, 0), cA, voffA); PG8_STAGE(PG8_SB(0, 1), cB + hstep, voffB); PG8_STAGE(PG8_SA(0, 1), cA + hstep, voffA);
        if (wr == 1) PG8_BAR;
        PG8_WAIT_V(4); PG8_BAR;
        PG8_STAGE(PG8_SB(1, 0), cB + kstep, voffB); PG8_STAGE(PG8_SA(1, 0), cA + kstep, voffA); PG8_STAGE(PG8_SB(1, 1), cB + hstep + kstep, voffB);
        PG8_WAIT_V(6); PG8_BAR;
    }
    for (;;) {
        const bool has_next = S.next(ui + 1, nxt);
        const char* nA = has_next ? (const char*)g.A + (size_t)nxt.pm * tstep : cA; const char* nB = has_next ? (const char*)g.Bt + (size_t)nxt.pn * tstep : cB;
        for (int t = 0; t < nt; t += 2) {
            const bool last = (t == nt - 2);
            if constexpr (Epi::PREFETCH) { if (t == nt - 4) E.prefetch(cur, lds + STAGE_BYTES + 1024, tid); }
            const char* a1 = cA + (size_t)(t + 1) * kstep;
            const char* a2 = last ? nA : cA + (size_t)(t + 2) * kstep; const char* b2 = last ? nB : cB + (size_t)(t + 2) * kstep;
            const char* a3 = a2 + kstep; const char* b3 = b2 + kstep;
            if (last && has_next) S.a_ready(nxt);
            if constexpr (SP2) {
            PG8_LDB(B0, 0, 0); PG8_LDB(B1, 0, 1); PG8_SCHED; PG8_LDA(At, 0, 0); PG8_STAGE(PG8_SA(1, 1), a1 + hstep, voffA);
            PG8_WAIT_V(8); PG8_WAIT_L(0); PG8_BAR; PG8_MMA(0, 0, At, B0); PG8_MMA(0, 1, At, B1); PG8_BAR; PG8_SCHED;
            PG8_LDA(At, 0, 1); PG8_STAGE(PG8_SB(0, 0), b2, voffB); PG8_STAGE(PG8_SB(0, 1), b2 + hstep, voffB); PG8_STAGE(PG8_SA(0, 0), a2, voffA);
            PG8_WAIT_V(8); PG8_WAIT_L(0); PG8_BAR; PG8_MMA(1, 0, At, B0); PG8_MMA(1, 1, At, B1); PG8_BAR; PG8_SCHED;
            PG8_LDB(B0, 1, 0); PG8_LDB(B1, 1, 1); PG8_SCHED; PG8_LDA(At, 1, 0); PG8_STAGE(PG8_SA(0, 1), a2 + hstep, voffA);
            PG8_WAIT_V(8); PG8_WAIT_L(0); PG8_BAR; PG8_MMA(0, 0, At, B0); PG8_MMA(0, 1, At, B1); PG8_BAR; PG8_SCHED;
            PG8_LDA(At, 1, 1); PG8_STAGE(PG8_SB(1, 0), b3, voffB); PG8_STAGE(PG8_SB(1, 1), b3 + hstep, voffB); PG8_STAGE(PG8_SA(1, 0), a3, voffA);
            PG8_WAIT_V(8); PG8_WAIT_L(0); PG8_BAR; PG8_MMA(1, 0, At, B0); PG8_MMA(1, 1, At, B1); PG8_BAR; PG8_SCHED;
            } else {
            PG8_LDB(B0, 0, 0); PG8_SCHED; PG8_LDA(At, 0, 0); PG8_STAGE(PG8_SA(1, 1), a1 + hstep, voffA);
            PG8_WAIT_L(8); PG8_BAR; PG8_WAIT_L(0); PG8_MMA(0, 0, At, B0); PG8_BAR; PG8_SCHED;
            PG8_LDB(B1, 0, 1); PG8_STAGE(PG8_SB(0, 0), b2, voffB);
            PG8_BAR; PG8_WAIT_L(0); PG8_MMA(0, 1, At, B1); PG8_BAR;
            PG8_LDA(At, 0, 1); PG8_STAGE(PG8_SA(0, 0), a2, voffA);
            PG8_BAR; PG8_WAIT_L(0); PG8_MMA(1, 0, At, B0); PG8_BAR; PG8_SCHED;
            PG8_STAGE(PG8_SB(0, 1), b2 + hstep, voffB);
            PG8_WAIT_V(6); PG8_BAR; PG8_MMA(1, 1, At, B1); PG8_BAR;
            PG8_LDB(B0, 1, 0); PG8_SCHED; PG8_LDA(At, 1, 0); PG8_STAGE(PG8_SA(0, 1), a2 + hstep, voffA);
            PG8_WAIT_L(8); PG8_BAR; PG8_WAIT_L(0); PG8_MMA(0, 0, At, B0); PG8_BAR; PG8_SCHED;
            PG8_LDB(B1, 1, 1); PG8_STAGE(PG8_SB(1, 0), b3, voffB);
            PG8_BAR; PG8_WAIT_L(0); PG8_MMA(0, 1, At, B1); PG8_BAR;
            PG8_LDA(At, 1, 1); PG8_STAGE(PG8_SA(1, 0), a3, voffA);
            PG8_BAR; PG8_WAIT_L(0); PG8_MMA(1, 0, At, B0); PG8_BAR; PG8_SCHED;
            PG8_STAGE(PG8_SB(1, 1), b3 + hstep, voffB);
            PG8_WAIT_V(6); PG8_BAR; PG8_MMA(1, 1, At, B1); PG8_BAR;
            }
        }
        if constexpr (ALIGN_EPI) { if (wr == 0) PG8_BAR; }
        if constexpr (!Epi::AFTER_DRAIN) { E(acc, cur, wr, wc, fr, fq); S.done(cur); }
        if (!has_next) break;
#pragma unroll
        for (int a = 0; a < 2; ++a)
#pragma unroll
            for (int b = 0; b < 2; ++b)
#pragma unroll
                for (int m = 0; m < 4; ++m)
#pragma unroll
                    for (int n = 0; n < 2; ++n) acc[a][b][m][n] = (f32x4){0.f, 0.f, 0.f, 0.f};
        cur = nxt; cA = nA; cB = nB; ++ui;
        if constexpr (ALIGN_EPI) { if (wr == 1) PG8_BAR; }
    }
    PG8_WAIT_V(0);
    if constexpr (!ALIGN_EPI) { if (wr == 0) PG8_BAR; }
    PG8_BAR;
    if constexpr (Epi::AFTER_DRAIN) { E.fused(acc, cur, wr, wc, fr, fq, lds, wid, lane); S.done(cur); }
#undef PG8_SA
#undef PG8_SB
#undef PG8_STAGE
#undef PG8_LDA
#undef PG8_LDB
#undef PG8_MMA
#undef PG8_WAIT_V
#undef PG8_WAIT_L
#undef PG8_BAR
#undef PG8_SCHED
}
}
#include <hip/hip_bf16.h>
#include <cmath>
namespace attn_body {
using bf16=__hip_bfloat16;
using bf16x8=__attribute__((ext_vector_type(8)))short;
using s16x4=__attribute__((ext_vector_type(4)))short;
using f32x16=__attribute__((ext_vector_type(16)))float;
using u32x4=__attribute__((ext_vector_type(4)))unsigned;
constexpr int BATCH=16,NHEAD=16,SEQ=2048,D=64,DM=NHEAD*D;
constexpr int NW=8,QBLK=32,QB=QBLK*NW,KVBLK=64,NQB=SEQ/QB;
constexpr int ATTN_PITCH=DM, ATTN_UNIT_ROWS=QB;
__device__ __forceinline__ int crow(int r,int hi){return (r&3)+8*(r>>2)+4*hi;}
#define SBAR() __builtin_amdgcn_sched_barrier(0)
__device__ __forceinline__ void cmask(f32x16&p0,f32x16&p1,int jb,int qrel,int hi){
  const float NEG=-INFINITY; int kb=64*jb+4*hi;
  #pragma unroll
  for(int r=0;r<16;++r){int kv=kb+(r&3)+8*(r>>2); if(kv>qrel)p0[r]=NEG; if(kv+32>qrel)p1[r]=NEG;}
}

constexpr int NSLOT=3, SLOTB=8192;
constexpr int LDS_K=0, LDS_V=NSLOT*SLOTB, LDS_WS=2*NSLOT*SLOTB, LDS_OST=LDS_WS+NW*64*4, LDS_CT=LDS_OST+NW*4096, LDS_BYTES=LDS_CT+SEQ*4+64;
constexpr float C2=0.125f*1.4426950408889634f;
__device__ __forceinline__ void glds16(const void*gsrc,unsigned lds_dst){unsigned keep;
  asm volatile("s_mov_b32 %0, m0\n\ts_mov_b32 m0, %2\n\ts_nop 0\n\tglobal_load_lds_dwordx4 %1, off\n\ts_mov_b32 m0, %0":"=&s"(keep):"v"(gsrc),"s"(lds_dst):"memory");}
__device__ __forceinline__ float max3f(float a,float b,float c){float r;asm("v_max3_f32 %0, %1, %2, %3":"=v"(r):"v"(a),"v"(b),"v"(c));return r;}
__device__ __forceinline__ float max2f(float a,float b){float r;asm("v_max_f32_e32 %0, %1, %2":"=v"(r):"v"(a),"v"(b));return r;}
__device__ __forceinline__ float fadd_s(float a,float b){float r;asm("v_add_f32_e32 %0, %1, %2":"=v"(r):"v"(a),"v"(b));return r;}
__device__ __forceinline__ float fsub_s(float a,float b){float r;asm("v_sub_f32_e32 %0, %1, %2":"=v"(r):"v"(a),"v"(b));return r;}
typedef float f32x2_t __attribute__((ext_vector_type(2))); typedef __bf16 bf16x2_t __attribute__((ext_vector_type(2)));
__device__ __forceinline__ unsigned cvtpk_s(float lo,float hi){f32x2_t v={lo,hi};bf16x2_t b=__builtin_convertvector(v,bf16x2_t);return __builtin_bit_cast(unsigned,b);}
#define WAIT_BAR(N) asm volatile("s_waitcnt vmcnt(" #N ") lgkmcnt(0)\n\ts_barrier":::"memory")

__device__ __forceinline__ void qkt(f32x16&p0,f32x16&p1,const char*Kslot,const bf16x8*qr,const f32x16&negm,int r32,int hi){
  const char*kb=Kslot+hi*1024+r32*16;
  #pragma unroll
  for(int d0=0;d0<4;++d0){
    const bf16x8 b0=*reinterpret_cast<const bf16x8*>(kb+d0*2048);
    const bf16x8 b1=*reinterpret_cast<const bf16x8*>(kb+d0*2048+512);
    if(d0==0){p0=__builtin_amdgcn_mfma_f32_32x32x16_bf16(b0,qr[0],negm,0,0,0);p1=__builtin_amdgcn_mfma_f32_32x32x16_bf16(b1,qr[0],negm,0,0,0);}
    else{p0=__builtin_amdgcn_mfma_f32_32x32x16_bf16(b0,qr[d0],p0,0,0,0);p1=__builtin_amdgcn_mfma_f32_32x32x16_bf16(b1,qr[d0],p1,0,0,0);}}
}
typedef __attribute__((address_space(3))) const char* lds_cptr;
typedef short v4i16_t __attribute__((ext_vector_type(4)));
__device__ __forceinline__ void kload8(bf16x8*kf,lds_cptr kp){
  kf[0]=*(const __attribute__((address_space(3))) bf16x8*)(kp);      kf[1]=*(const __attribute__((address_space(3))) bf16x8*)(kp+512);
  kf[2]=*(const __attribute__((address_space(3))) bf16x8*)(kp+2048); kf[3]=*(const __attribute__((address_space(3))) bf16x8*)(kp+2560);
  kf[4]=*(const __attribute__((address_space(3))) bf16x8*)(kp+4096); kf[5]=*(const __attribute__((address_space(3))) bf16x8*)(kp+4608);
  kf[6]=*(const __attribute__((address_space(3))) bf16x8*)(kp+6144); kf[7]=*(const __attribute__((address_space(3))) bf16x8*)(kp+6656);
}
__device__ __forceinline__ void kload2(bf16x8*kf,lds_cptr kp,int j){ kf[2*j]=*(const __attribute__((address_space(3))) bf16x8*)(kp+j*2048); kf[2*j+1]=*(const __attribute__((address_space(3))) bf16x8*)(kp+j*2048+512); }
__device__ __forceinline__ s16x4 vtr(lds_cptr p){ return __builtin_bit_cast(s16x4,__builtin_amdgcn_ds_read_tr16_b64_v4i16((__attribute__((address_space(3))) v4i16_t*)p)); }
__device__ __forceinline__ float rowmax(const f32x16&p0,const f32x16&p1){
  float a=max3f(p0[0],p0[1],p1[0]),b=max3f(p0[2],p0[3],p1[1]);a=max3f(a,p1[2],p1[3]);
  #pragma unroll
  for(int r=4;r<16;r+=4){a=max3f(a,p0[r],p0[r+1]);b=max3f(b,p0[r+2],p0[r+3]);a=max3f(a,p1[r],p1[r+1]);b=max3f(b,p1[r+2],p1[r+3]);}
  const float m=max2f(a,b);
  auto rr=__builtin_amdgcn_permlane32_swap(__float_as_uint(m),__float_as_uint(m),false,false);
  return max2f(__uint_as_float(rr[0]),__uint_as_float(rr[1]));
}
__device__ __forceinline__ void pv(f32x16*o,int vb,bf16x8 pa0,bf16x8 pa1,bf16x8 pa2,bf16x8 pa3){
  #pragma unroll
  for(int d0=0;d0<2;++d0){s16x4 lo[4],hi[4];
    #pragma unroll
    for(int ks=0;ks<4;++ks){
      asm volatile("ds_read_b64_tr_b16 %0,%1 offset:%c2":"=&v"(lo[ks]):"v"(vb),"i"(d0*4096+ks*1024):"memory");
      asm volatile("ds_read_b64_tr_b16 %0,%1 offset:%c2":"=&v"(hi[ks]):"v"(vb),"i"(d0*4096+ks*1024+512):"memory");}
    asm volatile("s_waitcnt lgkmcnt(0)":::"memory");SBAR();
    #define PK(k) (bf16x8){lo[k][0],lo[k][1],lo[k][2],lo[k][3],hi[k][0],hi[k][1],hi[k][2],hi[k][3]}
    o[d0]=__builtin_amdgcn_mfma_f32_32x32x16_bf16(pa0,PK(0),o[d0],0,0,0);
    o[d0]=__builtin_amdgcn_mfma_f32_32x32x16_bf16(pa1,PK(1),o[d0],0,0,0);
    o[d0]=__builtin_amdgcn_mfma_f32_32x32x16_bf16(pa2,PK(2),o[d0],0,0,0);
    o[d0]=__builtin_amdgcn_mfma_f32_32x32x16_bf16(pa3,PK(3),o[d0],0,0,0);
    #undef PK
  }
}

#ifndef ATTN_STORE16
#define ATTN_STORE16(p,v) (*(u32x4*)(p)=(v))
#endif
template<int THRL> __device__ __forceinline__ void attn_unit(int b,int h,int qb,const bf16*Q,const bf16*__restrict__ K,const bf16*__restrict__ V,bf16*O,char*shm){
  int tid_=threadIdx.x; asm volatile("":"+v"(tid_));
  const int tid=tid_,lane=tid&63,r32=lane&31,hi=lane>>5; const int wid=__builtin_amdgcn_readfirstlane(tid>>6);
  const long rowbase=(long)b*SEQ; const int q0=qb*QB;
  const bf16*Qw=Q+(rowbase+q0+wid*QBLK)*DM+h*D;
  const bf16*Kh=K+rowbase*DM+h*D,*Vh=V+rowbase*DM+h*D;
  const unsigned lds0=(unsigned)(uintptr_t)shm;
  float*wsf=(float*)(shm+LDS_WS)+wid*64;
  const bf16*ksrc=Kh+(long)lane*DM+wid*8;
  const bf16*vsrc=Vh+(long)(16*(wid&3)+(lane>>2))*DM+(wid>>2)*32+(lane&3)*8;
  const unsigned kdst=lds0+LDS_K+wid*1024, vdst=lds0+LDS_V+wid*1024;
  #define DMA_K(t,slot) glds16(ksrc+(long)(t)*KVBLK*DM,(unsigned)__builtin_amdgcn_readfirstlane(kdst+(slot)))
  #define DMA_V(t,slot) glds16(vsrc+(long)(t)*KVBLK*DM,(unsigned)__builtin_amdgcn_readfirstlane(vdst+(slot)))
  const int vb0=(int)(lds0+LDS_V)+((lane>>4)&1)*32+(lane&3)*8+(4*hi+((lane&15)>>2))*64;
  const char*Kbase=shm+LDS_K; bf16x8 kf[8];
  const lds_cptr shm3=(lds_cptr)shm; const lds_cptr kp0=shm3+LDS_K+hi*1024+r32*16; const lds_cptr vp0=shm3+LDS_V+((lane>>4)&1)*32+(lane&3)*8+(4*hi+((lane&15)>>2))*64;
  const int NT=(q0+QB)/KVBLK;
  DMA_K(0,0);DMA_V(0,0);DMA_K(1,SLOTB);
  bf16x8 qr[4];
  #pragma unroll
  for(int d0=0;d0<4;++d0)qr[d0]=*reinterpret_cast<const bf16x8*>(&Qw[(long)r32*DM+d0*16+hi*8]);
  float mhat=0.f,l_reg=0.f;float zz_=0.f;asm volatile("":"+v"(zz_));
  f32x16 o[2];o[0]=(f32x16){zz_,zz_,zz_,zz_,zz_,zz_,zz_,zz_,zz_,zz_,zz_,zz_,zz_,zz_,zz_,zz_};o[1]=o[0];f32x16 negm=o[0];asm volatile("":"+v"(negm));
  const int qrel=wid*QBLK+r32;
  #define CMASK(P0,P1,t) do{int jb_=(t)-(NT-4); if(jb_>=0)cmask(P0,P1,jb_,qrel,hi);}while(0)
  typedef float f32x4_t __attribute__((ext_vector_type(4)));
  const __attribute__((address_space(3))) float* ctl_=(const __attribute__((address_space(3))) float*)(shm3+LDS_CT)+4*hi;
  #define BIAS(P0,P1,t) do{ const __attribute__((address_space(3))) float* cb_=ctl_+64*(t); _Pragma("unroll") for(int g_=0;g_<4;++g_){ \
      const f32x4_t c0_=*(const __attribute__((address_space(3))) f32x4_t*)(cb_+8*g_), c1_=*(const __attribute__((address_space(3))) f32x4_t*)(cb_+32+8*g_); \
      P0[4*g_]-=c0_[0];P0[4*g_+1]-=c0_[1];P0[4*g_+2]-=c0_[2];P0[4*g_+3]-=c0_[3]; P1[4*g_]-=c1_[0];P1[4*g_+1]-=c1_[1];P1[4*g_+2]-=c1_[2];P1[4*g_+3]-=c1_[3]; } }while(0)
  bool resc=false;
  #define START(P0,P1) do{ const float rm=rowmax(P0,P1); resc=false; \
    { const float dl=rm; mhat=fadd_s(mhat,dl); \
      _Pragma("unroll") for(int r=0;r<16;++r){P0[r]=fsub_s(P0[r],dl);P1[r]=fsub_s(P1[r],dl);} \
      _Pragma("unroll") for(int r=0;r<16;++r)negm[r]=-mhat; asm volatile("":"+v"(negm)); } \
    _Pragma("unroll") for(int r=0;r<16;++r)P0[r]=__builtin_amdgcn_exp2f(P0[r]); }while(0)
  #define RESC() do{ if(resc){ asm volatile("s_waitcnt lgkmcnt(0)":::"memory"); \
      _Pragma("unroll") for(int d_=0;d_<2;++d_) _Pragma("unroll") for(int r=0;r<16;++r)o[d_][r]*=wsf[crow(r,hi)]; } }while(0)
  f32x16 pA0,pA1,pB0,pB1;
  int sl_prev=0,sl_cur=0,sl_next=SLOTB;
  #define ROT() do{sl_prev=sl_cur;sl_cur=sl_next;sl_next=(sl_next==(NSLOT-1)*SLOTB)?0:sl_next+SLOTB;}while(0)
  DMA_K(2,2*SLOTB);
  WAIT_BAR(3);
  qkt(pA0,pA1,Kbase,qr,negm,r32,hi);asm volatile("s_nop 15\n\ts_nop 7":"+v"(pA0),"+v"(pA1));BIAS(pA0,pA1,0);CMASK(pA0,pA1,0);
  START(pA0,pA1);
  _Pragma("unroll") for(int r=0;r<16;++r)pA1[r]=__builtin_amdgcn_exp2f(pA1[r]);
  WAIT_BAR(0);
  DMA_K(3,0);DMA_V(1,SLOTB);
  ROT();
  kload8(kf,kp0+sl_cur);
  WAIT_BAR(2);
  s16x4 vlo[8],vhi[8]; u32x4 pw0,pw1,pw2,pw3;
  #define PKW(P,B) cvtpk_s(P[B],P[B+1])
  #define PAF(k) __builtin_bit_cast(bf16x8,pw##k)
  #define VFR(i) (bf16x8){vlo[i][0],vlo[i][1],vlo[i][2],vlo[i][3],vhi[i][0],vhi[i][1],vhi[i][2],vhi[i][3]}
  #define PIN(x) asm volatile("":"+v"(x))
  #define MX3(a,b,c) __builtin_fmaxf(__builtin_fmaxf((a),(b)),(c))
  #define GAPA(MF,A0,A1,A2,A3,W0,W1,PW) do{ MF; sacc+=A0; sacc+=A1; sacc+=A2; sacc+=A3; PIN(sacc); W0; W1; PIN(PW); SBAR(); }while(0)
  #define EX(v) __builtin_amdgcn_exp2f(v)
  #define GAPB(MF,X,B) do{ MF; X[B]=EX(X[B]); X[B+1]=EX(X[B+1]); X[B+2]=EX(X[B+2]); X[B+3]=EX(X[B+3]); PIN(X); SBAR(); }while(0)
  #define VRD(i) do{ vlo[i]=vtr(vp_+(((i)>>2)*4096+((i)&3)*1024)); vhi[i]=vtr(vp_+(((i)>>2)*4096+((i)&3)*1024+512)); }while(0)
  #define KRD(G,j) do{ if(G){ kload2(kf,kp0+sl_next,j); SBAR(); } }while(0)
  #define STEP(C0,C1,P0,P1,t,GK,GV,GL) do{ SBAR(); \
    const lds_cptr vp_=vp0+sl_prev; \
    VRD(0); SBAR(); float sacc=(P0[0]+P0[1]); \
    GAPA(C0=__builtin_amdgcn_mfma_f32_32x32x16_bf16(kf[0],qr[0],negm,0,0,0), P0[2],P0[3],P0[4],P0[5],     pw0[0]=PKW(P0,0), pw0[1]=PKW(P0,2), pw0); \
    VRD(4); SBAR(); GAPA(C1=__builtin_amdgcn_mfma_f32_32x32x16_bf16(kf[1],qr[0],negm,0,0,0), P0[6],P0[7],P0[8],P0[9],     pw0[2]=PKW(P0,4), pw0[3]=PKW(P0,6), pw0); \
    VRD(1); SBAR(); GAPA(C0=__builtin_amdgcn_mfma_f32_32x32x16_bf16(kf[2],qr[1],C0,0,0,0),   P0[10],P0[11],P0[12],P0[13], pw1[0]=PKW(P0,8), pw1[1]=PKW(P0,10), pw1); \
    VRD(5); SBAR(); GAPA(C1=__builtin_amdgcn_mfma_f32_32x32x16_bf16(kf[3],qr[1],C1,0,0,0),   P0[14],P0[15],P1[0],P1[1],   pw1[2]=PKW(P0,12),pw1[3]=PKW(P0,14), pw1); \
    VRD(2); SBAR(); GAPA(C0=__builtin_amdgcn_mfma_f32_32x32x16_bf16(kf[4],qr[2],C0,0,0,0),   P1[2],P1[3],P1[4],P1[5],     pw2[0]=PKW(P1,0), pw2[1]=PKW(P1,2), pw2); \
    VRD(6); SBAR(); GAPA(C1=__builtin_amdgcn_mfma_f32_32x32x16_bf16(kf[5],qr[2],C1,0,0,0),   P1[6],P1[7],P1[8],P1[9],     pw2[2]=PKW(P1,4), pw2[3]=PKW(P1,6), pw2); \
    VRD(3); SBAR(); GAPA(C0=__builtin_amdgcn_mfma_f32_32x32x16_bf16(kf[6],qr[3],C0,0,0,0),   P1[10],P1[11],P1[12],P1[13], pw3[0]=PKW(P1,8), pw3[1]=PKW(P1,10), pw3); \
    VRD(7); SBAR(); GAPA(C1=__builtin_amdgcn_mfma_f32_32x32x16_bf16(kf[7],qr[3],C1,0,0,0),   P1[14],P1[15],0.f,0.f,       pw3[2]=PKW(P1,12),pw3[3]=PKW(P1,14), pw3); \
    l_reg+=sacc; \
    if(GK){DMA_K((t)+3,sl_cur);} if(GV){DMA_V((t)+1,sl_next);} \
    BIAS(C0,C1,t); CMASK(C0,C1,t); \
    { float a=MX3(C0[0],C0[1],C1[0]),b=MX3(C0[2],C0[3],C1[1]); a=MX3(a,C1[2],C1[3]); \
      _Pragma("unroll") for(int r=4;r<16;r+=4){a=MX3(a,C0[r],C0[r+1]);b=MX3(b,C0[r+2],C0[r+3]);a=MX3(a,C1[r],C1[r+1]);b=MX3(b,C1[r+2],C1[r+3]);} \
      float rm=__builtin_fmaxf(a,b); { auto rr=__builtin_amdgcn_permlane32_swap(__float_as_uint(rm),__float_as_uint(rm),false,false); rm=__builtin_fmaxf(__uint_as_float(rr[0]),__uint_as_float(rr[1])); } \
      resc=false; \
      if(__builtin_expect(__any(rm>(float)THRL),0)){ const float dl=__builtin_fmaxf(rm,0.f); mhat+=dl; \
        _Pragma("unroll") for(int r=0;r<16;++r){C0[r]-=dl;C1[r]-=dl;} \
        _Pragma("unroll") for(int r=0;r<16;++r)negm[r]=-mhat; asm volatile("":"+v"(negm)); \
        const float f=__builtin_amdgcn_exp2f(-dl); l_reg*=f; if(hi==0)wsf[r32]=f; resc=true; } } \
    SBAR(); \
    GAPB(o[0]=__builtin_amdgcn_mfma_f32_32x32x16_bf16(PAF(0),VFR(0),o[0],0,0,0), C0,0); \
    GAPB(o[1]=__builtin_amdgcn_mfma_f32_32x32x16_bf16(PAF(0),VFR(4),o[1],0,0,0), C0,4); \
    KRD(GL,0); GAPB(o[0]=__builtin_amdgcn_mfma_f32_32x32x16_bf16(PAF(1),VFR(1),o[0],0,0,0), C0,8); \
    KRD(GL,1); GAPB(o[1]=__builtin_amdgcn_mfma_f32_32x32x16_bf16(PAF(1),VFR(5),o[1],0,0,0), C0,12); \
    KRD(GL,2); GAPB(o[0]=__builtin_amdgcn_mfma_f32_32x32x16_bf16(PAF(2),VFR(2),o[0],0,0,0), C1,0); \
    KRD(GL,3); GAPB(o[1]=__builtin_amdgcn_mfma_f32_32x32x16_bf16(PAF(2),VFR(6),o[1],0,0,0), C1,4); \
    GAPB(o[0]=__builtin_amdgcn_mfma_f32_32x32x16_bf16(PAF(3),VFR(3),o[0],0,0,0), C1,8); \
    GAPB(o[1]=__builtin_amdgcn_mfma_f32_32x32x16_bf16(PAF(3),VFR(7),o[1],0,0,0), C1,12); \
    }while(0)
  int t=1;
  #undef CMASK
  #define CMASK(P0,P1,t) do{}while(0)
  for(;t+5<NT;t+=2){
    STEP(pB0,pB1,pA0,pA1,t,true,true,true);     WAIT_BAR(2); RESC(); ROT();
    STEP(pA0,pA1,pB0,pB1,t+1,true,true,true);   WAIT_BAR(2); RESC(); ROT();
  }
  #undef CMASK
  #define CMASK(P0,P1,t) do{int jb_=(t)-(NT-4); if(jb_>=0)cmask(P0,P1,jb_,qrel,hi);}while(0)
  #define ENDW(tt) do{ if((tt)+3<NT){WAIT_BAR(2);} else if((tt)+2<NT){WAIT_BAR(1);} else {WAIT_BAR(0);} }while(0)
  for(;t+1<NT;t+=2){
    STEP(pB0,pB1,pA0,pA1,t,(t+3<NT),(t+1<NT),(t+1<NT));       ENDW(t);   RESC(); ROT();
    STEP(pA0,pA1,pB0,pB1,t+1,(t+4<NT),(t+2<NT),(t+2<NT));     ENDW(t+1); RESC(); ROT();
  }
  STEP(pB0,pB1,pA0,pA1,NT-1,false,false,false); RESC();
  { float sacc=pB0[0]+pB0[1]; _Pragma("unroll") for(int r=2;r<16;++r)sacc+=pB0[r]; _Pragma("unroll") for(int r=0;r<16;++r)sacc+=pB1[r]; l_reg+=sacc;
    pw0=(u32x4){PKW(pB0,0),PKW(pB0,2),PKW(pB0,4),PKW(pB0,6)};pw1=(u32x4){PKW(pB0,8),PKW(pB0,10),PKW(pB0,12),PKW(pB0,14)};pw2=(u32x4){PKW(pB1,0),PKW(pB1,2),PKW(pB1,4),PKW(pB1,6)};pw3=(u32x4){PKW(pB1,8),PKW(pB1,10),PKW(pB1,12),PKW(pB1,14)};
    SBAR(); pv(o,vb0+sl_cur,PAF(0),PAF(1),PAF(2),PAF(3)); }
  #undef PKW
  #undef PAF
  #undef VFR
  #undef PIN
  #undef MX3
  #undef GAPA
  #undef GAPB
  #undef EX
  #undef VRD
  #undef KRD
  #undef STEP
  #undef ENDW
  {auto rr=__builtin_amdgcn_permlane32_swap(__float_as_uint(l_reg),__float_as_uint(l_reg),false,false);l_reg=__uint_as_float(rr[0])+__uint_as_float(rr[1]);}
  if(hi==0)wsf[32+r32]=l_reg;asm volatile("s_waitcnt lgkmcnt(0)":::"memory");
  float rli[16];
  #pragma unroll
  for(int r=0;r<16;++r)rli[r]=__builtin_amdgcn_rcpf(wsf[32+crow(r,hi)]);
  bf16*Ow=O+(rowbase+q0+wid*QBLK)*DM+h*D;
  { bf16*stg=(bf16*)(shm+LDS_OST)+wid*2048;
    #pragma unroll
    for(int r=0;r<16;++r){const int orow=crow(r,hi);
      #pragma unroll
      for(int d0=0;d0<2;++d0)stg[orow*64+d0*32+r32]=__float2bfloat16(o[d0][r]*rli[r]);}
    asm volatile("s_waitcnt lgkmcnt(0)":::"memory");
    #pragma unroll
    for(int i=0;i<4;++i){const int row=i*8+(lane>>3),ch=lane&7; const u32x4 v=*(const u32x4*)(stg+row*64+ch*8); ATTN_STORE16(Ow+(long)row*DM+ch*8,v);} }
  asm volatile("s_waitcnt lgkmcnt(0)\n\ts_barrier":::"memory");
  #undef DMA_K
  #undef DMA_V
  #undef CMASK
  #undef BIAS
  #undef START
  #undef RESC
  #undef ROT
}
constexpr int ATTN_LDS_BYTES=LDS_BYTES;
struct AttnTensors { const bf16* Q; const bf16* K; const bf16* V; bf16* O; };
struct AttnUnit { int bh; int qb; };
struct StaticOrder {
  int vcu;
  __device__ __forceinline__ explicit StaticOrder(int grid,int block):vcu((block%8)*(grid/8)+block/8){}
  __device__ __forceinline__ bool next(int i,AttnUnit&u)const{ if(i>=4)return false; const int s=vcu&7; u.bh=vcu>>3; u.qb=(i==0)?s:(i==1)?15-s:(i==2)?16+s:31-s; return true; }
  __device__ __forceinline__ void a_ready(const AttnUnit&)const{}
  __device__ __forceinline__ void done(const AttnUnit&)const{}
};
template<class Sched,int THRL=8> __device__ __forceinline__ void attn_phase(char*lds,const AttnTensors&T,const Sched&S){
  AttnUnit u;
  for(int i=0;S.next(i,u);++i){ S.a_ready(u); attn_unit<THRL>(u.bh/NHEAD,u.bh%NHEAD,u.qb,T.Q,T.K,T.V,T.O,lds); S.done(u); }
}
#undef SBAR
#undef WAIT_BAR
}
#ifndef PG8_SP2
#define PG8_SP2 true
#endif
#ifndef PG8_ALIGN
#define PG8_ALIGN true
#endif
#ifndef EN_PRO
#define EN_PRO 1
#endif
#ifndef EN_GU
#define EN_GU 1
#endif
#ifndef EN_RES
#define EN_RES 1
#endif
#ifndef EN_QKV
#define EN_QKV 1
#endif
#ifndef EN_ATT
#define EN_ATT 1
#endif
#ifndef EN_FIN
#define EN_FIN 1
#endif
#ifndef MK_N_LAUNCHES
#define MK_N_LAUNCHES 1
#endif

constexpr int BATCH = 16, SEQ = 2048, D = 1024, FF = 2816, NH = 16, HD = 64, M = BATCH * SEQ;
constexpr int NQKV_FOX = 3 * D, NQKV_SWA = 1280, NFOX_IN = 3 * D + NH, WIN = 128;
constexpr float C2 = 0.125f * 1.4426950408889634f;
constexpr float L2E = 1.4426950408889634f;
constexpr int NPH = 16;

constexpr size_t MiB = 1u << 20;
constexpr size_t WS_ROWSS = 5 * MiB;
constexpr size_t WS_LFT = 2 * MiB;
constexpr size_t WS_WF = 4 * MiB;
constexpr size_t WS_W = 8 * MiB, FFN_STRIDE = 17 * MiB, WD_OFF = 11 * MiB;
constexpr size_t WS_WFOX = 76 * MiB, WS_WOFOX = 82 * MiB, WS_WSWA = 84 * MiB, WS_WOSWA = 87 * MiB;
constexpr size_t WS_HB = 96 * MiB;
constexpr size_t WS_ACT = 160 * MiB;
constexpr size_t WS_O = WS_ACT + 192 * MiB;
constexpr size_t WS_END = 416 * MiB;

constexpr int LDS_BYTES = 147456;
#define LAS __attribute__((address_space(3)))
typedef unsigned short bf16;
typedef float f32x4 __attribute__((ext_vector_type(4)));
typedef float f32x16 __attribute__((ext_vector_type(16)));
typedef short bf16x8 __attribute__((ext_vector_type(8)));
typedef short s16x4 __attribute__((ext_vector_type(4)));
typedef unsigned u32x4 __attribute__((ext_vector_type(4)));
typedef unsigned u32x2 __attribute__((ext_vector_type(2)));
#define LDS_WAIT() asm volatile("s_waitcnt lgkmcnt(0)" ::: "memory")

__device__ __forceinline__ unsigned pk2(float lo, float hi) { return pg8::cvt_pk_bf16(lo, hi); }
__device__ __forceinline__ float wave_sum(float v) {
#pragma unroll
    for (int o = 1; o < 64; o <<= 1) v += __shfl_xor(v, o);
    return v;
}

#define XB_TMO      128
#define XB_XCNT(j)  (256  + 64 * (j))
#define XB_XSUB(j)  (1280 + 64 * (j))
#define XB_XGEN(j)  (2304 + 64 * (j))
#define XB_TOP      3328
#define XB_TOPGEN   3392
#define XCD_BAR_WORDS 3456
#define XB_SPIN_CAP (1u << 18)

__device__ __forceinline__ unsigned xb_ld(unsigned* p)              { return __hip_atomic_load(p, __ATOMIC_RELAXED, __HIP_MEMORY_SCOPE_AGENT); }
__device__ __forceinline__ unsigned xb_add(unsigned* p, unsigned v) { return __hip_atomic_fetch_add(p, v, __ATOMIC_RELAXED, __HIP_MEMORY_SCOPE_AGENT); }
__device__ __forceinline__ unsigned xb_poll(unsigned* p) { unsigned r; const unsigned z = 0u; asm volatile("global_atomic_add %0, %1, %2, off sc0\n\ts_waitcnt vmcnt(0)" : "=v"(r) : "v"(p), "v"(z) : "memory"); return r; }
__device__ __forceinline__ unsigned xb_xcc_id() { return (unsigned)__builtin_amdgcn_s_getreg((3 << 11) | 20) & 0xFu; }
#define XB_SPIN(cond, bar) do { unsigned _sp = 0; while (cond) { __builtin_amdgcn_s_sleep(1); \
    if ((++_sp & 255u) == 0u) { if (xb_ld(&(bar)[XB_TMO])) break; if (_sp > XB_SPIN_CAP) { atomicAdd(&(bar)[XB_TMO], 1u); break; } } } } while (0)

struct XcdBarrier {
    unsigned* bar; unsigned x; unsigned total;
    volatile LAS unsigned* st;
};

__device__ __forceinline__ XcdBarrier xcd_barrier_post(unsigned* bar, volatile LAS unsigned* st, unsigned total) {
    XcdBarrier b; b.bar = bar; b.x = xb_xcc_id(); b.st = st; b.total = total;
    if (threadIdx.x == 0) (void)xb_add(&bar[XB_XCNT(b.x)], 1u);
    return b;
}
__device__ __forceinline__ void xcd_barrier_complete(unsigned* bar, unsigned x, unsigned& nloc, unsigned& nx, unsigned total) {
    const unsigned G = total;
    unsigned sum, cnt, mine, sp = 0u;
    for (;;) {
        sum = 0u; cnt = 0u; mine = 0u;
#pragma unroll
        for (unsigned j = 0; j < 16; ++j) { const unsigned c = xb_ld(&bar[XB_XCNT(j)]); sum += c; cnt += (c > 0u) ? 1u : 0u; mine = (j == x) ? c : mine; }
        if (sum == G) break;
        __builtin_amdgcn_s_sleep(1);
        if ((++sp & 255u) == 0u) { if (xb_ld(&bar[XB_TMO])) break; if (sp > XB_SPIN_CAP) { atomicAdd(&bar[XB_TMO], 1u); break; } }
    }
    nloc = mine > 0u ? mine : 1u; nx = cnt > 0u ? cnt : 1u;
}

__device__ __forceinline__ void xcd_barrier(const XcdBarrier& b, const char* pfp = nullptr, unsigned pfstride = 0u, LAS unsigned char* pfdummy = nullptr) {
    asm volatile("s_waitcnt vmcnt(0)" ::: "memory");
    __syncthreads();
    if (pfp != nullptr && threadIdx.x >= 64) { const unsigned t = threadIdx.x - 64u;
        __builtin_amdgcn_global_load_lds((const unsigned*)(pfp + (size_t)(t >> 1) * pfstride + (t & 1u) * 128u), (LAS unsigned*)pfdummy, 4, 0, 0); }
    if (threadIdx.x == 0) {
        unsigned* bar = b.bar;
        __builtin_amdgcn_s_waitcnt(0);
        unsigned nloc = b.st[0], nx = b.st[1];
        if (nloc == 0u) { xcd_barrier_complete(bar, b.x, nloc, nx, b.total); b.st[0] = nloc; b.st[1] = nx; }
        const unsigned old = xb_add(&bar[XB_XSUB(b.x)], 1u);
        const unsigned gen = old / nloc;
        if (nx == 1u) {
            XB_SPIN(xb_poll(&bar[XB_XSUB(b.x)]) < (gen + 1u) * nloc, bar);
            __builtin_amdgcn_fence(__ATOMIC_ACQUIRE, "agent");
            asm volatile("s_waitcnt vmcnt(0)" ::: "memory");
        } else
        if (old + 1u == (gen + 1u) * nloc) {
            __builtin_amdgcn_fence(__ATOMIC_RELEASE, "agent");
            asm volatile("s_waitcnt vmcnt(0)" ::: "memory");
            const unsigned og = xb_add(&bar[XB_TOP], 1u);
            const unsigned tg = og / nx;
            if (og + 1u == (tg + 1u) * nx) xb_add(&bar[XB_TOPGEN], 1u);
            else XB_SPIN(xb_ld(&bar[XB_TOPGEN]) == tg, bar);
            __builtin_amdgcn_fence(__ATOMIC_ACQUIRE, "agent");
            xb_add(&bar[XB_XGEN(b.x)], 1u);
            asm volatile("s_waitcnt vmcnt(0)" ::: "memory");
        } else {
            XB_SPIN(xb_ld(&bar[XB_XGEN(b.x)]) == gen, bar);
            __builtin_amdgcn_fence(__ATOMIC_ACQUIRE, "agent");
            asm volatile("s_waitcnt vmcnt(0)" ::: "memory");
        }
    }
    __syncthreads();
}

__device__ __forceinline__ void p0_item(const float* W, int Nsrc, int k0, int csrc, int nvalid, const float* gain, bf16* WT, int K, int drow, LAS float* scr, int lane) {
    const int n4 = (lane & 7) * 4, kr = lane >> 3;
    f32x4 v[8]; float gv[8];
#pragma unroll
    for (int i = 0; i < 8; ++i) { const int kk = kr + 8 * i;
        v[i] = (n4 < nvalid) ? *(const f32x4*)(W + (size_t)(k0 + kk) * Nsrc + csrc + n4) : (f32x4){0.f, 0.f, 0.f, 0.f};
        gv[i] = gain ? gain[k0 + kk] : 1.0f; }
#pragma unroll
    for (int i = 0; i < 8; ++i) { const int kk = kr + 8 * i; LAS float* d = scr + kk * 33 + n4; const f32x4 w = v[i] * gv[i]; d[0] = w.x; d[1] = w.y; d[2] = w.z; d[3] = w.w; }
    LDS_WAIT(); asm volatile("" ::: "memory");
    const int c = lane & 7;
#pragma unroll
    for (int j = 0; j < 4; ++j) { const int n = (lane >> 3) + 8 * j; const LAS float* s = scr + (8 * c) * 33 + n;
        u32x4 o; o.x = pk2(s[0 * 33], s[1 * 33]); o.y = pk2(s[2 * 33], s[3 * 33]); o.z = pk2(s[4 * 33], s[5 * 33]); o.w = pk2(s[6 * 33], s[7 * 33]);
        if (n < nvalid) *(u32x4*)(WT + (size_t)(drow + n) * K + k0 + 8 * c) = o; }
    LDS_WAIT(); asm volatile("" ::: "memory");
}

struct Args { const float* in[26]; float* out; unsigned char* ws; int ph_lo, ph_hi; };

__device__ __forceinline__ void p0_prologue(const Args& a, LAS unsigned char* lds, int gw, int NGW, int wave, int lane) {
    LAS float* scr = (LAS float*)(lds + wave * 16384);
    unsigned char* ws = a.ws;
    constexpr int I_G = (D / 64) * (FF / 32), I_D = (FF / 64) * (D / 32), I_FFN = 2 * I_G + I_D;
    constexpr int I_FOX = (D / 64) * (NQKV_FOX / 32), I_F = D / 64, I_O = (D / 64) * (D / 32), I_SWA = (D / 64) * (NQKV_SWA / 32);
    constexpr int NITEMS = 4 * I_FFN + I_FOX + I_F + I_O + I_SWA + I_O;
    for (int it = gw; it < NITEMS; it += NGW) {
        int r = it;
        if (r < 4 * I_FFN) {
            const int f = r / I_FFN; r -= f * I_FFN;
            const int kind = r / I_G; r -= kind * I_G;
            const int ib = f == 0 ? 1 : f == 1 ? 9 : f == 2 ? 13 : 21;
            const float* gain = a.in[ib]; const float* wg = a.in[ib + 1]; const float* wu = a.in[ib + 2]; const float* wd = a.in[ib + 3];
            bf16* Wgu = (bf16*)(ws + WS_W + f * FFN_STRIDE); bf16* Wd = (bf16*)(ws + WS_W + f * FFN_STRIDE + WD_OFF);
            if (kind < 2) { const int nblk = FF / 32, kb = r / nblk, nb = r % nblk, n0 = 32 * nb;
                p0_item(kind == 0 ? wg : wu, FF, 64 * kb, n0, 32, gain, Wgu, D, 256 * (n0 / 128) + 128 * kind + (n0 % 128), scr, lane); }
            else { const int nblk = D / 32, kb = r / nblk, nb = r % nblk; p0_item(wd, D, 64 * kb, 32 * nb, 32, nullptr, Wd, FF, 32 * nb, scr, lane); }
            continue;
        }
        r -= 4 * I_FFN;
        if (r < I_FOX) { const int nblk = NQKV_FOX / 32, kb = r / nblk, nb = r % nblk; p0_item(a.in[6], NFOX_IN, 64 * kb, 32 * nb, 32, a.in[5], (bf16*)(ws + WS_WFOX), D, 32 * nb, scr, lane); continue; }
        r -= I_FOX;
        if (r < I_F) { p0_item(a.in[6], NFOX_IN, 64 * r, NQKV_FOX, 16, a.in[5], (bf16*)(ws + WS_WF), D, 0, scr, lane); continue; }
        r -= I_F;
        if (r < I_O) { const int nblk = D / 32, kb = r / nblk, nb = r % nblk; p0_item(a.in[8], D, 64 * kb, 32 * nb, 32, nullptr, (bf16*)(ws + WS_WOFOX), D, 32 * nb, scr, lane); continue; }
        r -= I_O;
        if (r < I_SWA) { const int nblk = NQKV_SWA / 32, kb = r / nblk, nb = r % nblk; p0_item(a.in[18], NQKV_SWA, 64 * kb, 32 * nb, 32, a.in[17], (bf16*)(ws + WS_WSWA), D, 32 * nb, scr, lane); continue; }
        r -= I_SWA;
        { const int nblk = D / 32, kb = r / nblk, nb = r % nblk; p0_item(a.in[20], D, 64 * kb, 32 * nb, 32, nullptr, (bf16*)(ws + WS_WOSWA), D, 32 * nb, scr, lane); }
    }
    { pg8::rss_t* rs = (pg8::rss_t*)(ws + WS_ROWSS) + M; for (int i = gw * 64 + lane; i < 5 * M; i += NGW * 64) rs[i] = 0ull; }
    { const float* x = a.in[0]; bf16* HB = (bf16*)(ws + WS_HB); pg8::rss_t* rs0 = (pg8::rss_t*)(ws + WS_ROWSS);
      for (int m = 2 * gw; m < M; m += 2 * NGW) { const f32x4* xr = (const f32x4*)(x + (size_t)m * D) + lane; f32x4 v[8]; float s0 = 0.f, s1 = 0.f;
#pragma unroll
          for (int j = 0; j < 8; ++j) v[j] = xr[64 * j];
#pragma unroll
          for (int j = 0; j < 4; ++j) { s0 += (v[j].x * v[j].x + v[j].y * v[j].y) + (v[j].z * v[j].z + v[j].w * v[j].w); s1 += (v[4 + j].x * v[4 + j].x + v[4 + j].y * v[4 + j].y) + (v[4 + j].z * v[4 + j].z + v[4 + j].w * v[4 + j].w); }
          s0 = wave_sum(s0); s1 = wave_sum(s1); if (lane == 0) { rs0[m] = pg8::rss_fix(s0); rs0[m + 1] = pg8::rss_fix(s1); }
          u32x2* o8 = (u32x2*)(HB + (size_t)m * D) + lane;
#pragma unroll
          for (int j = 0; j < 8; ++j) { u32x2 w; w.x = pk2(v[j].x, v[j].y); w.y = pk2(v[j].z, v[j].w); o8[64 * j] = w; } } }
}

__device__ __forceinline__ void fgate(const bf16* HB, const bf16* WF, const pg8::rss_t* rowss, const float* bfg, float* LFT, int gx, int ngrp, int gwl, int NGWL, int lane) {
    const int fr = lane & 15, fq = lane >> 4;
    const int per = (M / 16) / ngrp;
    for (int gi = gwl; gi < per; gi += NGWL) { const int grp = gx * per + gi;
        const int row = grp * 16 + fr;
        const bf16* ap = HB + (size_t)row * D + 8 * fq; const bf16* wp = WF + (size_t)fr * D + 8 * fq;
        f32x4 acc = {0.f, 0.f, 0.f, 0.f};
#pragma unroll 8
        for (int k = 0; k < D; k += 32) { const bf16x8 av = *(const bf16x8*)(ap + k); const bf16x8 wv = *(const bf16x8*)(wp + k); acc = __builtin_amdgcn_mfma_f32_16x16x32_bf16(wv, av, acc, 0, 0, 0); }
        const float rs = pg8::rstd_of(rowss, row); const int b = row / SEQ, s = row % SEQ;
#pragma unroll
        for (int i = 0; i < 4; ++i) { const int j = 4 * fq + i; const float xv = acc[i] * rs + bfg[j];
            const float ls = -(fmaxf(-xv, 0.f) + log1pf(expf(-fabsf(xv))));
            LFT[((size_t)(b * NH + j)) * SEQ + s] = ls; }
    }
}

__device__ __forceinline__ int crow(int r, int hi) { return (r & 3) + 8 * (r >> 2) + 4 * hi; }
#define MFMA32(a, b, c) __builtin_amdgcn_mfma_f32_32x32x16_bf16(a, b, c, 0, 0, 0)
template <int MODE>
__device__ __forceinline__ void attn_cu(LAS unsigned char* lds, const bf16* Qp, int qpitch, const bf16* Kp, const bf16* Vp, int kvpitch, bf16* Op, int opitch, int b, const float* lft_bh, float slope2, float sink2) {
    const int tid = threadIdx.x, lane = tid & 63, wid = tid >> 6, r32 = lane & 31, hi = lane >> 5;
    LAS bf16* Ks = (LAS bf16*)lds;
    LAS bf16* Vt = (LAS bf16*)(lds + 9216);
    LAS float* ctab = (LAS float*)(lds + 18432);
    LAS float* wsum = (LAS float*)(lds + 18432 + 8192);
    const float NEG = -INFINITY;
    if (MODE == 0) {
        __syncthreads();
        f32x4 v = *(const f32x4*)(lft_bh + 4 * tid);
        v.y += v.x; v.z += v.y; v.w += v.z;
        const float tot = v.w; float inc = tot;
#pragma unroll
        for (int o = 1; o < 64; o <<= 1) { const float n = __shfl_up(inc, o); if (lane >= o) inc += n; }
        if (lane == 63) wsum[wid] = inc;
        __syncthreads();
        float off = inc - tot;
        for (int w = 0; w < 8; ++w) { const float ws_ = wsum[w]; if (w < wid) off += ws_; }
        *(LAS f32x4*)(ctab + 4 * tid) = (f32x4){(v.x + off) * L2E, (v.y + off) * L2E, (v.z + off) * L2E, (v.w + off) * L2E};
    }
    for (int qb = 0; qb < SEQ / 256; ++qb) {
        const int q0 = qb * 256, qrow = q0 + wid * 32 + r32;
        const bf16* qptr = Qp + (size_t)(b * SEQ + qrow) * qpitch;
        bf16x8 qr[4];
#pragma unroll
        for (int d0 = 0; d0 < 4; ++d0) qr[d0] = *(const bf16x8*)(qptr + d0 * 16 + hi * 8);
        float m = -1e30f, l = 0.f; f32x16 o0 = {}, o1 = {};
        const int t0 = (MODE == 1) ? (q0 >= WIN ? (q0 - WIN) / 64 : 0) : 0, t1 = (q0 + 256) / 64;
        for (int t = t0; t < t1; ++t) {
            __syncthreads();
            { const int row = tid >> 3, ch = tid & 7; const size_t g = (size_t)(b * SEQ + 64 * t + row) * kvpitch + ch * 8;
              const u32x4 kk = *(const u32x4*)(Kp + g); *(LAS u32x4*)(Ks + row * 72 + ch * 8) = kk;
              const bf16x8 vv = *(const bf16x8*)(Vp + g);
#pragma unroll
              for (int j = 0; j < 8; ++j) Vt[(ch * 8 + j) * 72 + row] = (bf16)vv[j]; }
            __syncthreads();
            f32x16 p0 = {}, p1 = {};
#pragma unroll
            for (int d0 = 0; d0 < 4; ++d0) { const bf16x8 a0 = *(const LAS bf16x8*)(Ks + r32 * 72 + d0 * 16 + hi * 8), a1 = *(const LAS bf16x8*)(Ks + (32 + r32) * 72 + d0 * 16 + hi * 8);
                p0 = MFMA32(a0, qr[d0], p0); p1 = MFMA32(a1, qr[d0], p1); }
            const int kvb = 64 * t + 4 * hi;
#pragma unroll
            for (int r = 0; r < 16; ++r) { const int kvA = kvb + (r & 3) + 8 * (r >> 2), kvB = kvA + 32;
                if (MODE == 0) { p0[r] -= ctab[kvA]; p1[r] -= ctab[kvB]; if (kvA > qrow) p0[r] = NEG; if (kvB > qrow) p1[r] = NEG; }
                else { const int dA = qrow - kvA, dB = qrow - kvB; p0[r] -= slope2 * (float)dA; p1[r] -= slope2 * (float)dB;
                    if (dA < 0 || dA >= WIN) p0[r] = NEG; if (dB < 0 || dB >= WIN) p1[r] = NEG; } }
            float rm = fmaxf(p0[0], p1[0]);
#pragma unroll
            for (int r = 1; r < 16; ++r) rm = fmaxf(rm, fmaxf(p0[r], p1[r]));
            rm = fmaxf(rm, __shfl_xor(rm, 32));
            const float mn = fmaxf(m, rm), alpha = __builtin_amdgcn_exp2f(m - mn); m = mn;
            float s = 0.f;
#pragma unroll
            for (int r = 0; r < 16; ++r) { p0[r] = __builtin_amdgcn_exp2f(p0[r] - mn); p1[r] = __builtin_amdgcn_exp2f(p1[r] - mn); s += p0[r] + p1[r]; }
            l = l * alpha + s;
#pragma unroll
            for (int r = 0; r < 16; ++r) { o0[r] *= alpha; o1[r] *= alpha; }
            u32x4 pw[4];
            pw[0] = (u32x4){pk2(p0[0], p0[1]), pk2(p0[2], p0[3]), pk2(p0[4], p0[5]), pk2(p0[6], p0[7])};
            pw[1] = (u32x4){pk2(p0[8], p0[9]), pk2(p0[10], p0[11]), pk2(p0[12], p0[13]), pk2(p0[14], p0[15])};
            pw[2] = (u32x4){pk2(p1[0], p1[1]), pk2(p1[2], p1[3]), pk2(p1[4], p1[5]), pk2(p1[6], p1[7])};
            pw[3] = (u32x4){pk2(p1[8], p1[9]), pk2(p1[10], p1[11]), pk2(p1[12], p1[13]), pk2(p1[14], p1[15])};
#pragma unroll
            for (int c = 0; c < 4; ++c) { const bf16x8 pf = __builtin_bit_cast(bf16x8, pw[c]);
                { const LAS bf16* vp = Vt + r32 * 72 + 16 * c + 4 * hi; const s16x4 lo = *(const LAS s16x4*)vp, hh = *(const LAS s16x4*)(vp + 8);
                  const bf16x8 vf = {lo[0], lo[1], lo[2], lo[3], hh[0], hh[1], hh[2], hh[3]}; o0 = MFMA32(vf, pf, o0); }
                { const LAS bf16* vp = Vt + (32 + r32) * 72 + 16 * c + 4 * hi; const s16x4 lo = *(const LAS s16x4*)vp, hh = *(const LAS s16x4*)(vp + 8);
                  const bf16x8 vf = {lo[0], lo[1], lo[2], lo[3], hh[0], hh[1], hh[2], hh[3]}; o1 = MFMA32(vf, pf, o1); } }
        }
        l += __shfl_xor(l, 32);
        if (MODE == 1) l += __builtin_amdgcn_exp2f(sink2 - m);
        const float inv = 1.0f / l;
        bf16* optr = Op + (size_t)(b * SEQ + qrow) * opitch;
#pragma unroll
        for (int g = 0; g < 4; ++g) { const int d = 8 * g + 4 * hi;
            u32x2 w0; w0.x = pk2(o0[4 * g] * inv, o0[4 * g + 1] * inv); w0.y = pk2(o0[4 * g + 2] * inv, o0[4 * g + 3] * inv); *(u32x2*)(optr + d) = w0;
            u32x2 w1; w1.x = pk2(o1[4 * g] * inv, o1[4 * g + 1] * inv); w1.y = pk2(o1[4 * g + 2] * inv, o1[4 * g + 3] * inv); *(u32x2*)(optr + 32 + d) = w1; }
    }
    __syncthreads();
}

__device__ __forceinline__ void fox_phase(unsigned char* ldsg, const bf16* Q, const bf16* K, const bf16* V, bf16* O, const float* LFT, int gx, int ngrp, int gj, int gsize) {
    LAS float* ctab = (LAS float*)((LAS unsigned char*)ldsg + attn_body::LDS_CT);
    LAS float* wsum = ctab + SEQ;
    const int per = (BATCH * NH) / ngrp;
    for (int bi = gj; bi < per; bi += gsize) { const int bh = gx * per + bi;
        int tid_ = threadIdx.x; asm volatile("" : "+v"(tid_));
        const int tid = tid_, lane = tid & 63, wid = tid >> 6;
        __syncthreads();
        f32x4 v = *(const f32x4*)(LFT + (size_t)bh * SEQ + 4 * tid);
        v.y += v.x; v.z += v.y; v.w += v.z;
        const float tot = v.w; float inc = tot;
#pragma unroll
        for (int o = 1; o < 64; o <<= 1) { const float n = __shfl_up(inc, o); if (lane >= o) inc += n; }
        if (lane == 63) wsum[wid] = inc;
        __syncthreads();
        float off = inc - tot;
        for (int w = 0; w < 8; ++w) { const float ws_ = wsum[w]; if (w < wid) off += ws_; }
        *(LAS f32x4*)(ctab + 4 * tid) = (f32x4){(v.x + off) * L2E, (v.y + off) * L2E, (v.z + off) * L2E, (v.w + off) * L2E};
        __syncthreads();
        for (int qb = SEQ / 256 - 1; qb >= 0; --qb)
            attn_body::attn_unit<48>(bh / NH, bh % NH, qb, (const attn_body::bf16*)Q, (const attn_body::bf16*)K, (const attn_body::bf16*)V, (attn_body::bf16*)O, (char*)ldsg);
    }
}

__device__ __forceinline__ void swa_phase(LAS unsigned char* lds, const bf16* QKV, bf16* O, const float* sinks, int gx, int ngrp, int gj, int gsize) {
    const int tid = threadIdx.x, lane = tid & 63, wid = tid >> 6, r32 = lane & 31, hi = lane >> 5;
    LAS bf16* Kb = (LAS bf16*)lds;
    LAS bf16* Vt = (LAS bf16*)(lds + 36864);
    const float NEG = -INFINITY;
    const int per = (BATCH * 2 * (SEQ / WIN)) / ngrp;
    for (int ii = gj; ii < per; ii += gsize) { const int item = gx * per + ii;
        const int b = item / 32, kvh = (item >> 4) & 1, blk = item & 15;
        __syncthreads();
#pragma unroll
        for (int pass = 0; pass < 4; ++pass) { const int j = pass * 64 + (tid >> 3), ch = tid & 7, pos = WIN * (blk - 1) + j;
            u32x4 kk = {0u, 0u, 0u, 0u}; bf16x8 vv = {0, 0, 0, 0, 0, 0, 0, 0};
            if (pos >= 0) { const size_t g = (size_t)(b * SEQ + pos) * NQKV_SWA + D + kvh * HD + ch * 8; kk = *(const u32x4*)(QKV + g); vv = *(const bf16x8*)(QKV + g + 2 * HD); }
            *(LAS u32x4*)(Kb + j * 72 + ch * 8) = kk;
#pragma unroll
            for (int jj = 0; jj < 8; ++jj) Vt[(ch * 8 + jj) * 264 + j] = (bf16)vv[jj]; }
        __syncthreads();
        const int h = kvh * 8 + wid;
        const float slope2 = exp2f(-8.0f * (float)(h + 1) / 16.0f) * L2E, sink2 = sinks[h] * L2E;
        for (int i = 0; i < 4; ++i) {
            const int qin = 32 * i + r32, qrow = WIN * blk + qin;
            const bf16* qptr = QKV + (size_t)(b * SEQ + qrow) * NQKV_SWA + h * HD;
            bf16x8 qr[4];
#pragma unroll
            for (int d0 = 0; d0 < 4; ++d0) qr[d0] = *(const bf16x8*)(qptr + d0 * 16 + hi * 8);
            float m = -1e30f, l = 0.f; f32x16 o0 = {}, o1 = {};
            const int jt0 = (i < 2) ? 0 : 1;
            const float lc = -slope2 * (float)(WIN + qin - 4 * hi);
#pragma unroll
            for (int js = 0; js < 3; ++js) { const int jt = jt0 + js;
                if (blk == 0 && jt < 2) continue;
                const float tb = lc + slope2 * (float)(64 * jt);
                f32x16 p0, p1;
#pragma unroll
                for (int r = 0; r < 16; ++r) { const float kr = (float)((r & 3) + 8 * (r >> 2)); p0[r] = __builtin_fmaf(slope2, kr, tb); p1[r] = __builtin_fmaf(slope2, kr + 32.0f, tb); }
#pragma unroll
                for (int d0 = 0; d0 < 4; ++d0) { const bf16x8 a0 = *(const LAS bf16x8*)(Kb + (64 * jt + r32) * 72 + d0 * 16 + hi * 8), a1 = *(const LAS bf16x8*)(Kb + (64 * jt + 32 + r32) * 72 + d0 * 16 + hi * 8);
                    p0 = MFMA32(a0, qr[d0], p0); p1 = MFMA32(a1, qr[d0], p1); }
                if (js != 1) {
                    const int d00 = WIN + qin - (64 * jt + 4 * hi);
#pragma unroll
                    for (int r = 0; r < 16; ++r) { const int kr = (r & 3) + 8 * (r >> 2); const int dA = d00 - kr, dB = dA - 32;
                        if (js == 0) { if (dA >= WIN) p0[r] = NEG; if (dB >= WIN) p1[r] = NEG; }
                        else { if (dA < 0) p0[r] = NEG; if (dB < 0) p1[r] = NEG; } }
                }
                float rm = fmaxf(p0[0], p1[0]);
#pragma unroll
                for (int r = 1; r < 16; ++r) rm = fmaxf(rm, fmaxf(p0[r], p1[r]));
                rm = fmaxf(rm, __shfl_xor(rm, 32));
                const float mn = fmaxf(m, rm), alpha = __builtin_amdgcn_exp2f(m - mn); m = mn;
                float s = 0.f;
#pragma unroll
                for (int r = 0; r < 16; ++r) { p0[r] = __builtin_amdgcn_exp2f(p0[r] - mn); p1[r] = __builtin_amdgcn_exp2f(p1[r] - mn); s += p0[r] + p1[r]; }
                l = l * alpha + s;
#pragma unroll
                for (int r = 0; r < 16; ++r) { o0[r] *= alpha; o1[r] *= alpha; }
                u32x4 pw[4];
                pw[0] = (u32x4){pk2(p0[0], p0[1]), pk2(p0[2], p0[3]), pk2(p0[4], p0[5]), pk2(p0[6], p0[7])};
                pw[1] = (u32x4){pk2(p0[8], p0[9]), pk2(p0[10], p0[11]), pk2(p0[12], p0[13]), pk2(p0[14], p0[15])};
                pw[2] = (u32x4){pk2(p1[0], p1[1]), pk2(p1[2], p1[3]), pk2(p1[4], p1[5]), pk2(p1[6], p1[7])};
                pw[3] = (u32x4){pk2(p1[8], p1[9]), pk2(p1[10], p1[11]), pk2(p1[12], p1[13]), pk2(p1[14], p1[15])};
#pragma unroll
                for (int c = 0; c < 4; ++c) { const bf16x8 pf = __builtin_bit_cast(bf16x8, pw[c]);
                    { const LAS bf16* vp = Vt + r32 * 264 + 64 * jt + 16 * c + 4 * hi; const s16x4 lo = *(const LAS s16x4*)vp, hh = *(const LAS s16x4*)(vp + 8);
                      const bf16x8 vf = {lo[0], lo[1], lo[2], lo[3], hh[0], hh[1], hh[2], hh[3]}; o0 = MFMA32(vf, pf, o0); }
                    { const LAS bf16* vp = Vt + (32 + r32) * 264 + 64 * jt + 16 * c + 4 * hi; const s16x4 lo = *(const LAS s16x4*)vp, hh = *(const LAS s16x4*)(vp + 8);
                      const bf16x8 vf = {lo[0], lo[1], lo[2], lo[3], hh[0], hh[1], hh[2], hh[3]}; o1 = MFMA32(vf, pf, o1); } }
            }
            l += __shfl_xor(l, 32);
            l += __builtin_amdgcn_exp2f(sink2 - m);
            const float inv = 1.0f / l;
            bf16* optr = O + (size_t)(b * SEQ + qrow) * D + h * HD;
#pragma unroll
            for (int g = 0; g < 4; ++g) { const int d = 8 * g + 4 * hi;
                u32x2 w0; w0.x = pk2(o0[4 * g] * inv, o0[4 * g + 1] * inv); w0.y = pk2(o0[4 * g + 2] * inv, o0[4 * g + 3] * inv); *(u32x2*)(optr + d) = w0;
                u32x2 w1; w1.x = pk2(o1[4 * g] * inv, o1[4 * g + 1] * inv); w1.y = pk2(o1[4 * g + 2] * inv, o1[4 * g + 3] * inv); *(u32x2*)(optr + 32 + d) = w1; }
        }
    }
    __syncthreads();
}

enum { K_PRO = 0, K_GU = 1, K_RES = 2, K_QKV = 3, K_ATT = 4, K_FIN = 5 };
__device__ __forceinline__ void group_barrier(unsigned* cnt, unsigned target) {
    asm volatile("s_waitcnt vmcnt(0)" ::: "memory");
    __syncthreads();
    if (threadIdx.x == 0) {
        __builtin_amdgcn_fence(__ATOMIC_RELEASE, "agent");
        asm volatile("s_waitcnt vmcnt(0)" ::: "memory");
        (void)__hip_atomic_fetch_add(cnt, 1u, __ATOMIC_RELAXED, __HIP_MEMORY_SCOPE_AGENT);
        unsigned sp = 0u;
        while (__hip_atomic_load(cnt, __ATOMIC_RELAXED, __HIP_MEMORY_SCOPE_AGENT) < target) { __builtin_amdgcn_s_sleep(1); if (++sp > (1u << 23)) break; }
        __builtin_amdgcn_fence(__ATOMIC_ACQUIRE, "agent");
        asm volatile("s_waitcnt vmcnt(0)" ::: "memory");
    }
    __syncthreads();
}
__device__ __forceinline__ const char* phase_first_weights(const int ph, unsigned char* ws, int G, int bx, unsigned& stride) {
    size_t off; int N, K;
    switch (ph) {
        case 1: off = WS_W + 0 * FFN_STRIDE; N = 2 * FF; K = D; break;
        case 2: off = WS_W + 0 * FFN_STRIDE + WD_OFF; N = D; K = FF; break;
        case 3: off = WS_WFOX; N = NQKV_FOX; K = D; break;
        case 5: off = WS_WOFOX; N = D; K = D; break;
        case 6: off = WS_W + 1 * FFN_STRIDE; N = 2 * FF; K = D; break;
        case 7: off = WS_W + 1 * FFN_STRIDE + WD_OFF; N = D; K = FF; break;
        case 8: off = WS_W + 2 * FFN_STRIDE; N = 2 * FF; K = D; break;
        case 9: off = WS_W + 2 * FFN_STRIDE + WD_OFF; N = D; K = FF; break;
        case 10: off = WS_WSWA; N = NQKV_SWA; K = D; break;
        case 12: off = WS_WOSWA; N = D; K = D; break;
        case 13: off = WS_W + 3 * FFN_STRIDE; N = 2 * FF; K = D; break;
        case 14: off = WS_W + 3 * FFN_STRIDE + WD_OFF; N = D; K = FF; break;
        default: stride = 0u; return nullptr;
    }
    pg8::StaticOrder S; S.init(M, N, G, bx); pg8::Unit u; if (!S.next(0, u)) { stride = 0u; return nullptr; }
    stride = (unsigned)(K * 2);
    return (const char*)(ws + off) + (size_t)u.pn * 256 * K * 2;
}
__device__ __forceinline__ void run_phase(const int ph, const Args& a, LAS unsigned char* lds, unsigned char* ldsg, const bool dummy = false) {
    const int tid = threadIdx.x, lane = tid & 63, wave = __builtin_amdgcn_readfirstlane(tid >> 6);
    const int G = gridDim.x, bx = blockIdx.x;
    const int gw = bx * 8 + wave, NGW = G * 8;
    const int ngrp = (G == 256) ? 8 : 1, gsize = G / ngrp, gx = bx % ngrp, gj = bx / ngrp;
    unsigned char* ws = a.ws;
    pg8::rss_t* RS = (pg8::rss_t*)(ws + WS_ROWSS);
    bf16* HB = (bf16*)(ws + WS_HB);
    const size_t rpg = (size_t)(M / ngrp), RPG = (256 * MiB) / ngrp;
    unsigned char* reg = ws + WS_ACT + (size_t)gx * RPG;
    bf16* ACT = (bf16*)(reg - (size_t)gx * rpg * FF * 2);
    bf16* QX = (bf16*)(reg - (size_t)gx * rpg * D * 2); bf16* KX = QX + rpg * D; bf16* VX = QX + 2 * rpg * D; bf16* OB = QX + 3 * rpg * D;
    bf16* SQKV = (bf16*)(reg - (size_t)gx * rpg * NQKV_SWA * 2);
    {

        int kind, f = 0, rsi = 0, rso = -1, lay = 0; float alpha = 0.5f;
        switch (ph) {
            case 0: kind = K_PRO; break;
            case 1: kind = K_GU; f = 0; rsi = 0; break;
            case 2: kind = K_RES; f = 0; rso = 1; break;
            case 3: kind = K_QKV; lay = 0; rsi = 1; break;
            case 4: kind = K_ATT; lay = 0; break;
            case 5: kind = K_RES; f = 4; rso = 2; alpha = 1.f; break;
            case 6: kind = K_GU; f = 1; rsi = 2; break;
            case 7: kind = K_RES; f = 1; rso = 3; break;
            case 8: kind = K_GU; f = 2; rsi = 3; break;
            case 9: kind = K_RES; f = 2; rso = 4; break;
            case 10: kind = K_QKV; lay = 1; rsi = 4; break;
            case 11: kind = K_ATT; lay = 1; break;
            case 12: kind = K_RES; f = 5; rso = 5; alpha = 1.f; break;
            case 13: kind = K_GU; f = 3; rsi = 5; break;
            case 14: kind = K_RES; f = 3; rso = -1; break;
            default: kind = K_FIN; break;
        }
        if (EN_PRO && kind == K_PRO) {
            p0_prologue(a, lds, gw, NGW, wave, lane);
        } else if (EN_GU && kind == K_GU) {
            pg8::Gemm g{HB, (const bf16*)(ws + WS_W + f * FFN_STRIDE), M, 2 * FF, D}; pg8::StaticOrder S; S.init(M, 2 * FF, G, bx);
            pg8::EpiSwiglu E{ACT, FF, RS + (size_t)rsi * M};
            pg8::gemm_phase<pg8::EpiSwiglu, pg8::StaticOrder, PG8_ALIGN, PG8_SP2>(lds, g, S, E);
        } else if (EN_RES && kind == K_RES) {
            const bf16* A = f < 4 ? ACT : OB; const int K = f < 4 ? FF : D;
            const bf16* W = f < 4 ? (const bf16*)(ws + WS_W + f * FFN_STRIDE + WD_OFF) : f == 4 ? (const bf16*)(ws + WS_WOFOX) : (const bf16*)(ws + WS_WOSWA);
            pg8::Gemm g{A, W, M, D, K}; pg8::StaticOrder S; S.init(M, D, G, bx);
            pg8::EpiResid E{ph == 2 ? a.in[0] : nullptr, HB, nullptr, dummy ? (bf16*)(ws + 416 * MiB) : HB, rso >= 0 ? (dummy ? (pg8::rss_t*)(ws + 480 * MiB) : RS + (size_t)rso * M) : nullptr, alpha};
            pg8::gemm_phase<pg8::EpiResid, pg8::StaticOrder, PG8_ALIGN, PG8_SP2>(lds, g, S, E);
        } else if (EN_QKV && kind == K_QKV) {
            if (lay == 0) fgate(HB, (const bf16*)(ws + WS_WF), RS + (size_t)rsi * M, a.in[7], (float*)(ws + WS_LFT), gx, ngrp, gj * 8 + wave, gsize * 8, lane);
            const int N = lay == 0 ? NQKV_FOX : NQKV_SWA;
            pg8::Gemm g{HB, lay == 0 ? (const bf16*)(ws + WS_WFOX) : (const bf16*)(ws + WS_WSWA), M, N, D}; pg8::StaticOrder S; S.init(M, N, G, bx);
            pg8::EpiScale E{lay == 0 ? QX : SQKV, lay == 0 ? D : NQKV_SWA, RS + (size_t)rsi * M, lay == 0 ? D : 0, rpg * D, 4, C2};
            pg8::gemm_phase<pg8::EpiScale, pg8::StaticOrder, PG8_ALIGN, PG8_SP2>(lds, g, S, E);
        } else if (EN_ATT && kind == K_ATT) {
            if (lay == 0) fox_phase(ldsg, QX, KX, VX, OB, (const float*)(ws + WS_LFT), gx, ngrp, gj, gsize);
            else swa_phase(lds, SQKV, OB, a.in[19], gx, ngrp, gj, gsize);
        } else if (EN_FIN) {
            const float* gfin = a.in[25];
            const int perm_ = M / ngrp;
            for (int mi = 2 * (gj * 8 + wave); mi < perm_; mi += 2 * gsize * 8) { const int m = gx * perm_ + mi;
                const u32x2* hr = (const u32x2*)(HB + (size_t)m * D) + lane; u32x2 hv[8];
#pragma unroll
                for (int j = 0; j < 8; ++j) hv[j] = hr[64 * j];
                f32x4 v[8]; float s0 = 0.f, s1 = 0.f;
#pragma unroll
                for (int j = 0; j < 8; ++j) { v[j] = (f32x4){__uint_as_float(hv[j].x << 16), __uint_as_float(hv[j].x & 0xffff0000u), __uint_as_float(hv[j].y << 16), __uint_as_float(hv[j].y & 0xffff0000u)};
                    const float q = (v[j].x * v[j].x + v[j].y * v[j].y) + (v[j].z * v[j].z + v[j].w * v[j].w); if (j < 4) s0 += q; else s1 += q; }
                const float r0 = __builtin_amdgcn_rsqf(wave_sum(s0) * (1.0f / 1024.0f) + 1e-6f), r1 = __builtin_amdgcn_rsqf(wave_sum(s1) * (1.0f / 1024.0f) + 1e-6f);
                f32x4* xr = (f32x4*)(a.out + (size_t)m * D) + lane;
#pragma unroll
                for (int j = 0; j < 8; ++j) { const f32x4 gg = *((const f32x4*)gfin + lane + 64 * (j & 3)); xr[64 * j] = v[j] * (j < 4 ? r0 : r1) * gg; } }
        }
    }
}
__global__ void __launch_bounds__(512, 2) fwd(Args a) {
    extern __shared__ __attribute__((aligned(16))) unsigned char lds_raw[];
    LAS unsigned char* lds = (LAS unsigned char*)lds_raw;
    cg::grid_group grid = cg::this_grid();
    volatile LAS unsigned* MISC = (volatile LAS unsigned*)(lds + 131072 + 320);
    if (threadIdx.x < 32) MISC[threadIdx.x] = 0u;
    __syncthreads();
    XcdBarrier bar = xcd_barrier_post((unsigned*)a.ws + 4096, MISC + 8, gridDim.x);
    if (a.ph_hi > NPH) grid.sync();
#define GRID_SYNC() xcd_barrier(bar)
    const int ngrp_ = (gridDim.x == 256) ? 8 : 1; const unsigned gsize_ = gridDim.x / ngrp_;
    XcdBarrier gbar = xcd_barrier_post((unsigned*)a.ws + 16384 + 4096 * (blockIdx.x % ngrp_), MISC + 10, gsize_);
#define GROUP_SYNC(k) do { unsigned pfs_; const char* pfp_ = phase_first_weights((k) + 1, a.ws, (int)gridDim.x, (int)blockIdx.x, pfs_); xcd_barrier(gbar, pfp_, pfs_, lds + 131072 + 1024); } while (0)
#ifndef DUP_PHASE
#define DUP_PHASE -1
#endif
#ifndef DUP_SYNC
#define DUP_SYNC 0
#endif
#define PHASE(k) if (a.ph_lo <= (k) && (k) < a.ph_hi) { run_phase((k), a, lds, lds_raw); if ((k) == DUP_PHASE) { GRID_SYNC(); run_phase((k), a, lds, lds_raw, true); } \
        if ((k) == 0) { for (int i_ = 0; i_ < DUP_SYNC; ++i_) GRID_SYNC(); } if ((k) + 1 < a.ph_hi) { if ((k) == 0 || a.ph_lo != 0) GRID_SYNC(); else GROUP_SYNC(k); } }
    PHASE(0) PHASE(1) PHASE(2) PHASE(3) PHASE(4) PHASE(5) PHASE(6) PHASE(7) PHASE(8) PHASE(9) PHASE(10) PHASE(11) PHASE(12) PHASE(13) PHASE(14) PHASE(15)
#undef PHASE
}

extern "C" void kernel_launch(void* const* d_in, const int* in_sizes, int n_in, void* d_out, int out_size, void* d_ws, size_t ws_size, hipStream_t stream) {
    static int grid = 0;
    if (grid == 0) {
        if (n_in != 26 || in_sizes[0] != M * D || out_size != M * D || ws_size < WS_END) { fprintf(stderr, "kernel_launch: unexpected shapes (n_in %d, in0 %d, out %d, ws %zu); nothing launched\n", n_in, n_in > 0 ? in_sizes[0] : -1, out_size, ws_size); grid = -1; return; }
        int dev = 0, cus = 0, per_cu = 0;
        if (hipGetDevice(&dev) != hipSuccess || hipDeviceGetAttribute(&cus, hipDeviceAttributeMultiprocessorCount, dev) != hipSuccess) { grid = -1; return; }
        if (hipFuncSetAttribute((const void*)fwd, hipFuncAttributeMaxDynamicSharedMemorySize, LDS_BYTES) != hipSuccess) { fprintf(stderr, "kernel_launch: hipFuncSetAttribute failed\n"); grid = -1; return; }
        if (hipOccupancyMaxActiveBlocksPerMultiprocessor(&per_cu, (const void*)fwd, 512, LDS_BYTES) != hipSuccess || per_cu < 1) { fprintf(stderr, "kernel_launch: occupancy query says %d blocks per CU\n", per_cu); per_cu = 1; }
        (void)hipGetLastError();
        grid = cus;
    }
    if (grid < 0) return;
    if (hipMemsetAsync(d_ws, 0, 262144, stream) != hipSuccess) { fprintf(stderr, "kernel_launch: hipMemsetAsync of the barrier words failed\n"); return; }
    Args a{};
    for (int i = 0; i < 26; ++i) a.in[i] = (const float*)d_in[i];
    a.out = (float*)d_out; a.ws = (unsigned char*)d_ws;
#if MK_N_LAUNCHES == 1
    a.ph_lo = 0; a.ph_hi = NPH;
    void* args[] = {&a};
    hipError_t e = hipLaunchCooperativeKernel((const void*)fwd, dim3(grid), dim3(512), args, LDS_BYTES, stream);
    if (e != hipSuccess) fprintf(stderr, "kernel_launch: cooperative launch failed: %s (grid %d)\n", hipGetErrorString(e), grid);
#else
    for (int ph = 0; ph < NPH; ++ph) { a.ph_lo = ph; a.ph_hi = ph + 1; hipLaunchKernelGGL(fwd, dim3(grid), dim3(512), LDS_BYTES, stream, a); }
#endif
}
```

```cpp
#include <hip/hip_runtime.h>
#include <hip/hip_cooperative_groups.h>
#include <cstdio>
#include <cstdint>
#include <cmath>
namespace cg = cooperative_groups;
namespace pg8 {
#define PG8_LAS __attribute__((address_space(3)))
typedef unsigned short bf16_t;
typedef short bf16x8 __attribute__((ext_vector_type(8)));
typedef float f32x4 __attribute__((ext_vector_type(4)));
typedef unsigned u32x4 __attribute__((ext_vector_type(4)));
constexpr int BM = 256, BK = 64, HALF = 128, HTB = HALF * BK * 2  , STAGE_BYTES = 8 * HTB, NXCD = 8, WGM = 4;

__host__ __device__ __forceinline__ int lds_byte(int r, int c) { const int st = (r >> 4) * 2 + (c >> 5), rr = r & 15, cc = c & 31, ob = rr * 64 + cc * 2; return st * 1024 + (ob ^ (((ob >> 9) & 1) << 5)); }
__host__ __device__ __forceinline__ void stage_rc(int b, int& R, int& C) { const int st = b / 1024, sb = b % 1024, swz = sb ^ (((sb >> 9) & 1) << 5); R = (st >> 1) * 16 + swz / 64; C = (st & 1) * 32 + (swz % 64) / 2; }
__host__ __device__ __forceinline__ int perm32(int rho) { const int n = rho >> 4, i = rho & 15; return 8 * (i >> 2) + 4 * n + (i & 3); }

struct Unit { int pm, pn; };
struct Gemm { const bf16_t* A; const bf16_t* Bt; int M, N, K; };

struct StaticOrder {
    int nM, nN, nwg, G, c;
    __host__ __device__ void init(int M, int N, int G_, int c_) { nM = M / BM; nN = N / BM; nwg = nM * nN; G = G_; c = c_; }
    __host__ __device__ bool next(int i, Unit& u) const {
        const long L = (long)i * G + c; if (L >= nwg) return false;
        int wgid = (int)L; { const int q = nwg / NXCD, r = nwg % NXCD, xcd = wgid % NXCD, off = wgid / NXCD; wgid = (xcd < r ? xcd * (q + 1) : r * (q + 1) + (xcd - r) * q) + off; }
        const int nig = WGM * nN, gid = wgid / nig, fm = gid * WGM, gsz = (nM - fm) < WGM ? (nM - fm) : WGM;
        u.pm = fm + ((wgid % nig) % gsz); u.pn = (wgid % nig) / gsz; return true;
    }
    __device__ __forceinline__ void a_ready(const Unit&) const {}
    __device__ __forceinline__ void done(const Unit&) const {}
};

__device__ __forceinline__ unsigned cvt_pk_bf16(float lo, float hi) { unsigned r; asm volatile("v_cvt_pk_bf16_f32 %0, %1, %2" : "=v"(r) : "v"(lo), "v"(hi)); return r; }
typedef float f32x2 __attribute__((ext_vector_type(2)));
typedef unsigned u32x2 __attribute__((ext_vector_type(2)));
typedef unsigned long long rss_t;
__device__ __forceinline__ float ld_agent(const rss_t* p) { return (float)__hip_atomic_load(p, __ATOMIC_RELAXED, __HIP_MEMORY_SCOPE_AGENT) * (1.0f / 16777216.0f); }
__device__ __forceinline__ rss_t rss_fix(float ss) { return (rss_t)(ss * 16777216.0f); }
__device__ __forceinline__ float rstd_of(const rss_t* rowss, int row) { return __builtin_amdgcn_rsqf(ld_agent(rowss + row) * (1.0f / 1024.0f) + 1e-6f); }
__device__ __forceinline__ unsigned silu_pk(f32x2 g, f32x2 u, float k1, float k2) {
    const f32x2 t = g * k1; f32x2 ex; ex.x = __builtin_amdgcn_exp2f(t.x); ex.y = __builtin_amdgcn_exp2f(t.y);
    const f32x2 d = ex + 1.0f; f32x2 r; r.x = __builtin_amdgcn_rcpf(d.x); r.y = __builtin_amdgcn_rcpf(d.y);
    const f32x2 o = (g * u) * (r * k2);
    return cvt_pk_bf16(o.x, o.y);
}
__device__ __forceinline__ float silu_mul(float g, float u) { return g * __builtin_amdgcn_rcpf(1.0f + __builtin_amdgcn_exp2f(-1.4426950408889634f * g)) * u; }

struct EpiSwiglu {
    static constexpr bool PERM = true, AFTER_DRAIN = false, PREFETCH = false;
    bf16_t* O; int ldc; const rss_t* rowss;
    __device__ __forceinline__ void operator()(const f32x4 (&acc)[2][2][4][2], const Unit& u, int wr, int wc, int fr, int fq) const {
        const int row0 = u.pm * BM + wr * 64 + fr, col0 = u.pn * HALF + wc * 32 + 8 * fq;
        float ssq[2][4];
#pragma unroll
        for (int ai = 0; ai < 2; ++ai)
#pragma unroll
            for (int m = 0; m < 4; ++m) ssq[ai][m] = ld_agent(rowss + row0 + ai * HALF + m * 16);
#pragma unroll
        for (int ai = 0; ai < 2; ++ai)
#pragma unroll
            for (int m = 0; m < 4; ++m) {
                const int row = row0 + ai * HALF + m * 16; const float rs = __builtin_amdgcn_rsqf(ssq[ai][m] * (1.0f / 1024.0f) + 1e-6f);
                const float k1 = -1.4426950408889634f * rs, k2 = rs * rs;
                u32x4 w;
#pragma unroll
                for (int n = 0; n < 2; ++n) {
                    const f32x4 gv = acc[ai][0][m][n], uv = acc[ai][1][m][n];
                    const unsigned lo = silu_pk((f32x2){gv[0], gv[1]}, (f32x2){uv[0], uv[1]}, k1, k2), hi = silu_pk((f32x2){gv[2], gv[3]}, (f32x2){uv[2], uv[3]}, k1, k2);
                    if (n == 0) { w.x = lo; w.y = hi; } else { w.z = lo; w.w = hi; }
                }
                *(u32x4*)(O + (size_t)row * ldc + col0) = w;
            }
    }
};
struct EpiScale {
    static constexpr bool PERM = true, AFTER_DRAIN = false, PREFETCH = false;
    bf16_t* O; int ldc; const rss_t* rowss; int split_cols; size_t split_stride; int qtiles; float qscale;
    __device__ __forceinline__ void operator()(const f32x4 (&acc)[2][2][4][2], const Unit& u, int wr, int wc, int fr, int fq) const {
        const int row0 = u.pm * BM + wr * 64 + fr; int colt = u.pn * BM; bf16_t* base = O;
        if (split_cols) { const int t = colt / split_cols; base += (size_t)t * split_stride; colt -= t * split_cols; }
        const float sc = (u.pn < qtiles) ? qscale : 1.0f;
        const int col0 = colt + wc * 32 + 8 * fq;
        float ssq[2][4];
#pragma unroll
        for (int ai = 0; ai < 2; ++ai)
#pragma unroll
            for (int m = 0; m < 4; ++m) ssq[ai][m] = ld_agent(rowss + row0 + ai * HALF + m * 16);
#pragma unroll
        for (int ai = 0; ai < 2; ++ai)
#pragma unroll
            for (int m = 0; m < 4; ++m) {
                const int row = row0 + ai * HALF + m * 16; const float rs = __builtin_amdgcn_rsqf(ssq[ai][m] * (1.0f / 1024.0f) + 1e-6f) * sc;
                bf16_t* rowp = base + (size_t)row * ldc + col0;
#pragma unroll
                for (int bj = 0; bj < 2; ++bj) { const f32x4 v0 = acc[ai][bj][m][0] * rs, v1 = acc[ai][bj][m][1] * rs;
                    u32x4 w; w.x = cvt_pk_bf16(v0[0], v0[1]); w.y = cvt_pk_bf16(v0[2], v0[3]); w.z = cvt_pk_bf16(v1[0], v1[1]); w.w = cvt_pk_bf16(v1[2], v1[3]);
                    *(u32x4*)(rowp + bj * HALF) = w; }
            }
    }
};
struct EpiResid {
    static constexpr bool PERM = true, AFTER_DRAIN = false, PREFETCH = false;
    const float* base32; const bf16_t* base16; float* out32; bf16_t* hb; rss_t* rowss_next; float alpha;
    __device__ __forceinline__ void operator()(const f32x4 (&acc)[2][2][4][2], const Unit& u, int wr, int wc, int fr, int fq) const {
        const int row0 = u.pm * BM + wr * 64 + fr, col0 = u.pn * BM + wc * 32 + 8 * fq;
        if (base32) {
            f32x4 pre[4][4];
#pragma unroll
            for (int m = 0; m < 4; ++m) { const size_t off = (size_t)(row0 + m * 16) * 1024 + col0;
#pragma unroll
                for (int bj = 0; bj < 2; ++bj) { pre[m][2 * bj] = *(const f32x4*)(base32 + off + bj * HALF); pre[m][2 * bj + 1] = *(const f32x4*)(base32 + off + bj * HALF + 4); } }
            asm volatile("" ::: "memory");
#pragma unroll
            for (int ai = 0; ai < 2; ++ai)
#pragma unroll
                for (int m = 0; m < 4; ++m) {
                    const int row = row0 + ai * HALF + m * 16; const size_t off = (size_t)row * 1024 + col0; float ss = 0.f;
#pragma unroll
                    for (int bj = 0; bj < 2; ++bj) {
                        const f32x4 v0 = pre[m][2 * bj] + acc[ai][bj][m][0] * alpha, v1 = pre[m][2 * bj + 1] + acc[ai][bj][m][1] * alpha;
                        store(off + bj * HALF, v0, v1, ss);
                    }
                    if (ai == 0) { const size_t off2 = off + (size_t)HALF * 1024;
#pragma unroll
                        for (int bj = 0; bj < 2; ++bj) { pre[m][2 * bj] = *(const f32x4*)(base32 + off2 + bj * HALF); pre[m][2 * bj + 1] = *(const f32x4*)(base32 + off2 + bj * HALF + 4); } }
                    rowsum(row, ss, fq);
                    asm volatile("" ::: "memory");
                }
        } else {
            u32x4 pre[2][4][2];
#pragma unroll
            for (int ai = 0; ai < 2; ++ai)
#pragma unroll
                for (int m = 0; m < 4; ++m) { const size_t off = (size_t)(row0 + ai * HALF + m * 16) * 1024 + col0;
#pragma unroll
                    for (int bj = 0; bj < 2; ++bj) pre[ai][m][bj] = *(const u32x4*)(base16 + off + bj * HALF); }
            asm volatile("" ::: "memory");
#pragma unroll
            for (int ai = 0; ai < 2; ++ai)
#pragma unroll
                for (int m = 0; m < 4; ++m) {
                    const int row = row0 + ai * HALF + m * 16; const size_t off = (size_t)row * 1024 + col0; float ss = 0.f;
#pragma unroll
                    for (int bj = 0; bj < 2; ++bj) { const u32x4 p = pre[ai][m][bj];
                        const f32x4 b0 = {__uint_as_float(p.x << 16), __uint_as_float(p.x & 0xffff0000u), __uint_as_float(p.y << 16), __uint_as_float(p.y & 0xffff0000u)};
                        const f32x4 b1 = {__uint_as_float(p.z << 16), __uint_as_float(p.z & 0xffff0000u), __uint_as_float(p.w << 16), __uint_as_float(p.w & 0xffff0000u)};
                        const f32x4 v0 = b0 + acc[ai][bj][m][0] * alpha, v1 = b1 + acc[ai][bj][m][1] * alpha;
                        store(off + bj * HALF, v0, v1, ss);
                    }
                    rowsum(row, ss, fq);
                    if (m & 1) asm volatile("" ::: "memory");
                }
        }
    }
    __device__ __forceinline__ void store(size_t o, const f32x4& v0, const f32x4& v1, float& ss) const {
        if (out32) { *(f32x4*)(out32 + o) = v0; *(f32x4*)(out32 + o + 4) = v1; }
        ss += (v0[0] * v0[0] + v0[1] * v0[1]) + (v0[2] * v0[2] + v0[3] * v0[3]) + (v1[0] * v1[0] + v1[1] * v1[1]) + (v1[2] * v1[2] + v1[3] * v1[3]);
        if (hb) { u32x4 w; w.x = cvt_pk_bf16(v0[0], v0[1]); w.y = cvt_pk_bf16(v0[2], v0[3]); w.z = cvt_pk_bf16(v1[0], v1[1]); w.w = cvt_pk_bf16(v1[2], v1[3]); *(u32x4*)(hb + o) = w; }
    }
    __device__ __forceinline__ void rowsum(int row, float ss, int fq) const {
        if (rowss_next) { ss += __shfl_xor(ss, 16); ss += __shfl_xor(ss, 32);
            if (fq == 0) (void)__hip_atomic_fetch_add(rowss_next + row, rss_fix(ss), __ATOMIC_RELAXED, __HIP_MEMORY_SCOPE_AGENT); }
    }
};
template <class Epi, class Sched, bool ALIGN_EPI = false, bool SP2 = false>
__device__ __forceinline__ void gemm_phase(PG8_LAS unsigned char* lds, const Gemm g, const Sched& S, const Epi& E) {
    const int tid = threadIdx.x, wid = __builtin_amdgcn_readfirstlane(tid >> 6), lane = tid & 63, wr = wid >> 2, wc = wid & 3, fr = lane & 15, fq = lane >> 4;
    const int K = g.K, nt = K / BK;
    unsigned voffA[2], voffB[2];
#pragma unroll
    for (int i = 0; i < 2; ++i) { int R, C; stage_rc(tid * 16 + i * 8192, R, C); const int Rb = Epi::PERM ? ((R & ~31) + perm32(R & 31)) : R;
        voffA[i] = (unsigned)(R * K + C) * 2u; voffB[i] = (unsigned)(Rb * K + C) * 2u; }
    const size_t kstep = (size_t)(BK * 2);
    const size_t hstep = (size_t)HALF * K * 2;
    const size_t tstep = 2 * hstep;
    const unsigned ldsw = (unsigned)wid * 1024u;
    const int aoff = lds_byte(wr * 64 + fr, fq * 8), boff = lds_byte(wc * 32 + fr, fq * 8);
#define PG8_SA(b, h) (((b) * 2 + (h)) * HTB)
#define PG8_SB(b, h) ((4 + (b) * 2 + (h)) * HTB)
#define PG8_STAGE(bufoff, gbase, voff) do { _Pragma("unroll") for (int _i = 0; _i < 2; ++_i) \
        __builtin_amdgcn_global_load_lds((const unsigned*)((const char*)(gbase) + (voff)[_i]), (PG8_LAS unsigned*)(lds + (bufoff) + ldsw + _i * 8192), 16, 0, 0); } while (0)
#define PG8_LDA(dst, b, h) do { _Pragma("unroll") for (int m = 0; m < 4; ++m) _Pragma("unroll") for (int k = 0; k < 2; ++k) dst[m][k] = *(const PG8_LAS bf16x8*)(lds + PG8_SA(b, h) + aoff + m * 2048 + k * 1024); } while (0)
#define PG8_LDB(dst, b, h) do { _Pragma("unroll") for (int n = 0; n < 2; ++n) _Pragma("unroll") for (int k = 0; k < 2; ++k) dst[n][k] = *(const PG8_LAS bf16x8*)(lds + PG8_SB(b, h) + boff + n * 2048 + k * 1024); } while (0)
#define PG8_MMA(ai, bj, At, Bt) do { __builtin_amdgcn_s_setprio(1); _Pragma("unroll") for (int m = 0; m < 4; ++m) _Pragma("unroll") for (int n = 0; n < 2; ++n) _Pragma("unroll") for (int k = 0; k < 2; ++k) \
        acc[ai][bj][m][n] = __builtin_amdgcn_mfma_f32_16x16x32_bf16(Bt[n][k], At[m][k], acc[ai][bj][m][n], 0, 0, 0); __builtin_amdgcn_s_setprio(0); } while (0)
#define PG8_WAIT_V(n) asm volatile("s_waitcnt vmcnt(" #n ")" ::: "memory")
#define PG8_WAIT_L(n) asm volatile("s_waitcnt lgkmcnt(" #n ")" ::: "memory")
#define PG8_BAR __builtin_amdgcn_s_barrier()
#define PG8_SCHED __builtin_amdgcn_sched_barrier(0)
    Unit cur, nxt; int ui = 0;
    if (!S.next(0, cur)) return;
    f32x4 acc[2][2][4][2];
#pragma unroll
    for (int a = 0; a < 2; ++a)
#pragma unroll
        for (int b = 0; b < 2; ++b)
#pragma unroll
            for (int m = 0; m < 4; ++m)
#pragma unroll
                for (int n = 0; n < 2; ++n) acc[a][b][m][n] = (f32x4){0.f, 0.f, 0.f, 0.f};
    bf16x8 At[4][2], B0[2][2], B1[2][2];
    const char* cA = (const char*)g.A + (size_t)cur.pm * tstep; const char* cB = (const char*)g.Bt + (size_t)cur.pn * tstep;
    S.a_ready(cur);
    if constexpr (SP2) {
        PG8_STAGE(PG8_SB(0, 0), cB, voffB); PG8_STAGE(PG8_SB(0, 1), cB + hstep, voffB); PG8_STAGE(PG8_SA(0, 0), cA, voffA); PG8_STAGE(PG8_SA(0, 1), cA + hstep, voffA);
        if (wr == 1) PG8_BAR;
        PG8_WAIT_V(2); PG8_BAR;
        PG8_STAGE(PG8_SB(1, 0), cB + kstep, voffB); PG8_STAGE(PG8_SA(1, 0), cA + kstep, voffA); PG8_STAGE(PG8_SB(1, 1), cB + hstep + kstep, voffB);
        PG8_WAIT_V(6); PG8_BAR;
    } else {
        PG8_STAGE(PG8_SB(0, 0), cB, voffB); PG8_STAGE(PG8_SA(0, 0), cA, voffA); PG8_STAGE(PG8_SB(0, 1), cB + hstep, voffB); PG8_STAGE(PG8_SA(0, 1), cA + hstep, voffA);
        if (wr == 1) PG8_BAR;
        PG8_WAIT_V(4); PG8_BAR;
        PG8_STAGE(PG8_SB(1, 0), cB + kstep, voffB); PG8_STAGE(PG8_SA(1, 0), cA + kstep, voffA); PG8_STAGE(PG8_SB(1, 1), cB + hstep + kstep, voffB);
        PG8_WAIT_V(6); PG8_BAR;
    }
    for (;;) {
        const bool has_next = S.next(ui + 1, nxt);
        const char* nA = has_next ? (const char*)g.A + (size_t)nxt.pm * tstep : cA; const char* nB = has_next ? (const char*)g.Bt + (size_t)nxt.pn * tstep : cB;
        for (int t = 0; t < nt; t += 2) {
            const bool last = (t == nt - 2);
            if constexpr (Epi::PREFETCH) { if (t == nt - 4) E.prefetch(cur, lds + STAGE_BYTES + 1024, tid); }
            const char* a1 = cA + (size_t)(t + 1) * kstep;
            const char* a2 = last ? nA : cA + (size_t)(t + 2) * kstep; const char* b2 = last ? nB : cB + (size_t)(t + 2) * kstep;
            const char* a3 = a2 + kstep; const char* b3 = b2 + kstep;
            if (last && has_next) S.a_ready(nxt);
            if constexpr (SP2) {
            PG8_LDB(B0, 0, 0); PG8_LDB(B1, 0, 1); PG8_SCHED; PG8_LDA(At, 0, 0); PG8_STAGE(PG8_SA(1, 1), a1 + hstep, voffA);
            PG8_WAIT_V(8); PG8_WAIT_L(0); PG8_BAR; PG8_MMA(0, 0, At, B0); PG8_MMA(0, 1, At, B1); PG8_BAR; PG8_SCHED;
            PG8_LDA(At, 0, 1); PG8_STAGE(PG8_SB(0, 0), b2, voffB); PG8_STAGE(PG8_SB(0, 1), b2 + hstep, voffB); PG8_STAGE(PG8_SA(0, 0), a2, voffA);
            PG8_WAIT_V(8); PG8_WAIT_L(0); PG8_BAR; PG8_MMA(1, 0, At, B0); PG8_MMA(1, 1, At, B1); PG8_BAR; PG8_SCHED;
            PG8_LDB(B0, 1, 0); PG8_LDB(B1, 1, 1); PG8_SCHED; PG8_LDA(At, 1, 0); PG8_STAGE(PG8_SA(0, 1), a2 + hstep, voffA);
            PG8_WAIT_V(8); PG8_WAIT_L(0); PG8_BAR; PG8_MMA(0, 0, At, B0); PG8_MMA(0, 1, At, B1); PG8_BAR; PG8_SCHED;
            PG8_LDA(At, 1, 1); PG8_STAGE(PG8_SB(1, 0), b3, voffB); PG8_STAGE(PG8_SB(1, 1), b3 + hstep, voffB); PG8_STAGE(PG8_SA(1, 0), a3, voffA);
            PG8_WAIT_V(8); PG8_WAIT_L(0); PG8_BAR; PG8_MMA(1, 0, At, B0); PG8_MMA(1, 1, At, B1); PG8_BAR; PG8_SCHED;
            } else {
            PG8_LDB(B0, 0, 0); PG8_SCHED; PG8_LDA(At, 0, 0); PG8_STAGE(PG8_SA(1, 1), a1 + hstep, voffA);
            PG8_WAIT_L(8); PG8_BAR; PG8_WAIT_L(0); PG8_MMA(0, 0, At, B0); PG8_BAR; PG8_SCHED;
            PG8_LDB(B1, 0, 1); PG8_STAGE(PG8_SB(0, 0), b2, voffB);
            PG8_BAR; PG8_WAIT_L(0); PG8_MMA(0, 1, At, B1); PG8_BAR;
            PG8_LDA(At, 0, 1); PG8_STAGE(PG8_SA(0, 0), a2, voffA);
            PG8_BAR; PG8_WAIT_L(0); PG8_MMA(1, 0, At, B0); PG8_BAR; PG8_SCHED;
            PG8_STAGE(PG8_SB(0, 1), b2 + hstep, voffB);
            PG8_WAIT_V(6); PG8_BAR; PG8_MMA(1, 1, At, B1); PG8_BAR;
            PG8_LDB(B0, 1, 0); PG8_SCHED; PG8_LDA(At, 1, 0); PG8_STAGE(PG8_SA(0, 1), a2 + hstep, voffA);
            PG8_WAIT_L(8); PG8_BAR; PG8_WAIT_L(0); PG8_MMA(0, 0, At, B0); PG8_BAR; PG8_SCHED;
            PG8_LDB(B1, 1, 1); PG8_STAGE(PG8_SB(1, 0), b3, voffB);
            PG8_BAR; PG8_WAIT_L(0); PG8_MMA(0, 1, At, B1); PG8_BAR;
            PG8_LDA(At, 1, 1); PG8_STAGE(PG8_SA(1, 0), a3, voffA);
            PG8_BAR; PG8_WAIT_L(0); PG8_MMA(1, 0, At, B0); PG8_BAR; PG8_SCHED;
            PG8_STAGE(PG8_SB(1, 1), b3 + hstep, voffB);
            PG8_WAIT_V(6); PG8_BAR; PG8_MMA(1, 1, At, B1); PG8_BAR;
            }
        }
        if constexpr (ALIGN_EPI) { if (wr == 0) PG8_BAR; }
        if constexpr (!Epi::AFTER_DRAIN) { E(acc, cur, wr, wc, fr, fq); S.done(cur); }
        if (!has_next) break;
#pragma unroll
        for (int a = 0; a < 2; ++a)
#pragma unroll
            for (int b = 0; b < 2; ++b)
#pragma unroll
                for (int m = 0; m < 4; ++m)
#pragma unroll
                    for (int n = 0; n < 2; ++n) acc[a][b][m][n] = (f32x4){0.f, 0.f, 0.f, 0.f};
        cur = nxt; cA = nA; cB = nB; ++ui;
        if constexpr (ALIGN_EPI) { if (wr == 1) PG8_BAR; }
    }
    PG8_WAIT_V(0);
    if constexpr (!ALIGN_EPI) { if (wr == 0) PG8_BAR; }
    PG8_BAR;
    if constexpr (Epi::AFTER_DRAIN) { E.fused(acc, cur, wr, wc, fr, fq, lds, wid, lane); S.done(cur); }
#undef PG8_SA
#undef PG8_SB
#undef PG8_STAGE
#undef PG8_LDA
#undef PG8_LDB
#undef PG8_MMA
#undef PG8_WAIT_V
#undef PG8_WAIT_L
#undef PG8_BAR
#undef PG8_SCHED
}
}
#include <hip/hip_bf16.h>
#include <cmath>
namespace attn_body {
using bf16=__hip_bfloat16;
using bf16x8=__attribute__((ext_vector_type(8)))short;
using s16x4=__attribute__((ext_vector_type(4)))short;
using f32x16=__attribute__((ext_vector_type(16)))float;
using u32x4=__attribute__((ext_vector_type(4)))unsigned;
constexpr int BATCH=16,NHEAD=16,SEQ=2048,D=64,DM=NHEAD*D;
constexpr int NW=8,QBLK=32,QB=QBLK*NW,KVBLK=64,NQB=SEQ/QB;
constexpr int ATTN_PITCH=DM, ATTN_UNIT_ROWS=QB;
__device__ __forceinline__ int crow(int r,int hi){return (r&3)+8*(r>>2)+4*hi;}
#define SBAR() __builtin_amdgcn_sched_barrier(0)
__device__ __forceinline__ void cmask(f32x16&p0,f32x16&p1,int jb,int qrel,int hi){
  const float NEG=-INFINITY; int kb=64*jb+4*hi;
  #pragma unroll
  for(int r=0;r<16;++r){int kv=kb+(r&3)+8*(r>>2); if(kv>qrel)p0[r]=NEG; if(kv+32>qrel)p1[r]=NEG;}
}

constexpr int NSLOT=3, SLOTB=8192;
constexpr int LDS_K=0, LDS_V=NSLOT*SLOTB, LDS_WS=2*NSLOT*SLOTB, LDS_OST=LDS_WS+NW*64*4, LDS_CT=LDS_OST+NW*4096, LDS_BYTES=LDS_CT+SEQ*4+64;
constexpr float C2=0.125f*1.4426950408889634f;
__device__ __forceinline__ void glds16(const void*gsrc,unsigned lds_dst){unsigned keep;
  asm volatile("s_mov_b32 %0, m0\n\ts_mov_b32 m0, %2\n\ts_nop 0\n\tglobal_load_lds_dwordx4 %1, off\n\ts_mov_b32 m0, %0":"=&s"(keep):"v"(gsrc),"s"(lds_dst):"memory");}
__device__ __forceinline__ float max3f(float a,float b,float c){float r;asm("v_max3_f32 %0, %1, %2, %3":"=v"(r):"v"(a),"v"(b),"v"(c));return r;}
__device__ __forceinline__ float max2f(float a,float b){float r;asm("v_max_f32_e32 %0, %1, %2":"=v"(r):"v"(a),"v"(b));return r;}
__device__ __forceinline__ float fadd_s(float a,float b){float r;asm("v_add_f32_e32 %0, %1, %2":"=v"(r):"v"(a),"v"(b));return r;}
__device__ __forceinline__ float fsub_s(float a,float b){float r;asm("v_sub_f32_e32 %0, %1, %2":"=v"(r):"v"(a),"v"(b));return r;}
typedef float f32x2_t __attribute__((ext_vector_type(2))); typedef __bf16 bf16x2_t __attribute__((ext_vector_type(2)));
__device__ __forceinline__ unsigned cvtpk_s(float lo,float hi){f32x2_t v={lo,hi};bf16x2_t b=__builtin_convertvector(v,bf16x2_t);return __builtin_bit_cast(unsigned,b);}
#define WAIT_BAR(N) asm volatile("s_waitcnt vmcnt(" #N ") lgkmcnt(0)\n\ts_barrier":::"memory")

__device__ __forceinline__ void qkt(f32x16&p0,f32x16&p1,const char*Kslot,const bf16x8*qr,const f32x16&negm,int r32,int hi){
  const char*kb=Kslot+hi*1024+r32*16;
  #pragma unroll
  for(int d0=0;d0<4;++d0){
    const bf16x8 b0=*reinterpret_cast<const bf16x8*>(kb+d0*2048);
    const bf16x8 b1=*reinterpret_cast<const bf16x8*>(kb+d0*2048+512);
    if(d0==0){p0=__builtin_amdgcn_mfma_f32_32x32x16_bf16(b0,qr[0],negm,0,0,0);p1=__builtin_amdgcn_mfma_f32_32x32x16_bf16(b1,qr[0],negm,0,0,0);}
    else{p0=__builtin_amdgcn_mfma_f32_32x32x16_bf16(b0,qr[d0],p0,0,0,0);p1=__builtin_amdgcn_mfma_f32_32x32x16_bf16(b1,qr[d0],p1,0,0,0);}}
}
typedef __attribute__((address_space(3))) const char* lds_cptr;
typedef short v4i16_t __attribute__((ext_vector_type(4)));
__device__ __forceinline__ void kload8(bf16x8*kf,lds_cptr kp){
  kf[0]=*(const __attribute__((address_space(3))) bf16x8*)(kp);      kf[1]=*(const __attribute__((address_space(3))) bf16x8*)(kp+512);
  kf[2]=*(const __attribute__((address_space(3))) bf16x8*)(kp+2048); kf[3]=*(const __attribute__((address_space(3))) bf16x8*)(kp+2560);
  kf[4]=*(const __attribute__((address_space(3))) bf16x8*)(kp+4096); kf[5]=*(const __attribute__((address_space(3))) bf16x8*)(kp+4608);
  kf[6]=*(const __attribute__((address_space(3))) bf16x8*)(kp+6144); kf[7]=*(const __attribute__((address_space(3))) bf16x8*)(kp+6656);
}
__device__ __forceinline__ void kload2(bf16x8*kf,lds_cptr kp,int j){ kf[2*j]=*(const __attribute__((address_space(3))) bf16x8*)(kp+j*2048); kf[2*j+1]=*(const __attribute__((address_space(3))) bf16x8*)(kp+j*2048+512); }
__device__ __forceinline__ s16x4 vtr(lds_cptr p){ return __builtin_bit_cast(s16x4,__builtin_amdgcn_ds_read_tr16_b64_v4i16((__attribute__((address_space(3))) v4i16_t*)p)); }
__device__ __forceinline__ float rowmax(const f32x16&p0,const f32x16&p1){
  float a=max3f(p0[0],p0[1],p1[0]),b=max3f(p0[2],p0[3],p1[1]);a=max3f(a,p1[2],p1[3]);
  #pragma unroll
  for(int r=4;r<16;r+=4){a=max3f(a,p0[r],p0[r+1]);b=max3f(b,p0[r+2],p0[r+3]);a=max3f(a,p1[r],p1[r+1]);b=max3f(b,p1[r+2],p1[r+3]);}
  const float m=max2f(a,b);
  auto rr=__builtin_amdgcn_permlane32_swap(__float_as_uint(m),__float_as_uint(m),false,false);
  return max2f(__uint_as_float(rr[0]),__uint_as_float(rr[1]));
}
__device__ __forceinline__ void pv(f32x16*o,int vb,bf16x8 pa0,bf16x8 pa1,bf16x8 pa2,bf16x8 pa3){
  #pragma unroll
  for(int d0=0;d0<2;++d0){s16x4 lo[4],hi[4];
    #pragma unroll
    for(int ks=0;ks<4;++ks){
      asm volatile("ds_read_b64_tr_b16 %0,%1 offset:%c2":"=&v"(lo[ks]):"v"(vb),"i"(d0*4096+ks*1024):"memory");
      asm volatile("ds_read_b64_tr_b16 %0,%1 offset:%c2":"=&v"(hi[ks]):"v"(vb),"i"(d0*4096+ks*1024+512):"memory");}
    asm volatile("s_waitcnt lgkmcnt(0)":::"memory");SBAR();
    #define PK(k) (bf16x8){lo[k][0],lo[k][1],lo[k][2],lo[k][3],hi[k][0],hi[k][1],hi[k][2],hi[k][3]}
    o[d0]=__builtin_amdgcn_mfma_f32_32x32x16_bf16(pa0,PK(0),o[d0],0,0,0);
    o[d0]=__builtin_amdgcn_mfma_f32_32x32x16_bf16(pa1,PK(1),o[d0],0,0,0);
    o[d0]=__builtin_amdgcn_mfma_f32_32x32x16_bf16(pa2,PK(2),o[d0],0,0,0);
    o[d0]=__builtin_amdgcn_mfma_f32_32x32x16_bf16(pa3,PK(3),o[d0],0,0,0);
    #undef PK
  }
}

#ifndef ATTN_STORE16
#define ATTN_STORE16(p,v) (*(u32x4*)(p)=(v))
#endif
template<int THRL> __device__ __forceinline__ void attn_unit(int b,int h,int qb,const bf16*Q,const bf16*__restrict__ K,const bf16*__restrict__ V,bf16*O,char*shm){
  int tid_=threadIdx.x; asm volatile("":"+v"(tid_));
  const int tid=tid_,lane=tid&63,r32=lane&31,hi=lane>>5; const int wid=__builtin_amdgcn_readfirstlane(tid>>6);
  const long rowbase=(long)b*SEQ; const int q0=qb*QB;
  const bf16*Qw=Q+(rowbase+q0+wid*QBLK)*DM+h*D;
  const bf16*Kh=K+rowbase*DM+h*D,*Vh=V+rowbase*DM+h*D;
  const unsigned lds0=(unsigned)(uintptr_t)shm;
  float*wsf=(float*)(shm+LDS_WS)+wid*64;
  const bf16*ksrc=Kh+(long)lane*DM+wid*8;
  const bf16*vsrc=Vh+(long)(16*(wid&3)+(lane>>2))*DM+(wid>>2)*32+(lane&3)*8;
  const unsigned kdst=lds0+LDS_K+wid*1024, vdst=lds0+LDS_V+wid*1024;
  #define DMA_K(t,slot) glds16(ksrc+(long)(t)*KVBLK*DM,(unsigned)__builtin_amdgcn_readfirstlane(kdst+(slot)))
  #define DMA_V(t,slot) glds16(vsrc+(long)(t)*KVBLK*DM,(unsigned)__builtin_amdgcn_readfirstlane(vdst+(slot)))
  const int vb0=(int)(lds0+LDS_V)+((lane>>4)&1)*32+(lane&3)*8+(4*hi+((lane&15)>>2))*64;
  const char*Kbase=shm+LDS_K; bf16x8 kf[8];
  const lds_cptr shm3=(lds_cptr)shm; const lds_cptr kp0=shm3+LDS_K+hi*1024+r32*16; const lds_cptr vp0=shm3+LDS_V+((lane>>4)&1)*32+(lane&3)*8+(4*hi+((lane&15)>>2))*64;
  const int NT=(q0+QB)/KVBLK;
  DMA_K(0,0);DMA_V(0,0);DMA_K(1,SLOTB);
  bf16x8 qr[4];
  #pragma unroll
  for(int d0=0;d0<4;++d0)qr[d0]=*reinterpret_cast<const bf16x8*>(&Qw[(long)r32*DM+d0*16+hi*8]);
  float mhat=0.f,l_reg=0.f;float zz_=0.f;asm volatile("":"+v"(zz_));
  f32x16 o[2];o[0]=(f32x16){zz_,zz_,zz_,zz_,zz_,zz_,zz_,zz_,zz_,zz_,zz_,zz_,zz_,zz_,zz_,zz_};o[1]=o[0];f32x16 negm=o[0];asm volatile("":"+v"(negm));
  const int qrel=wid*QBLK+r32;
  #define CMASK(P0,P1,t) do{int jb_=(t)-(NT-4); if(jb_>=0)cmask(P0,P1,jb_,qrel,hi);}while(0)
  typedef float f32x4_t __attribute__((ext_vector_type(4)));
  const __attribute__((address_space(3))) float* ctl_=(const __attribute__((address_space(3))) float*)(shm3+LDS_CT)+4*hi;
  #define BIAS(P0,P1,t) do{ const __attribute__((address_space(3))) float* cb_=ctl_+64*(t); _Pragma("unroll") for(int g_=0;g_<4;++g_){ \
      const f32x4_t c0_=*(const __attribute__((address_space(3))) f32x4_t*)(cb_+8*g_), c1_=*(const __attribute__((address_space(3))) f32x4_t*)(cb_+32+8*g_); \
      P0[4*g_]-=c0_[0];P0[4*g_+1]-=c0_[1];P0[4*g_+2]-=c0_[2];P0[4*g_+3]-=c0_[3]; P1[4*g_]-=c1_[0];P1[4*g_+1]-=c1_[1];P1[4*g_+2]-=c1_[2];P1[4*g_+3]-=c1_[3]; } }while(0)
  bool resc=false;
  #define START(P0,P1) do{ const float rm=rowmax(P0,P1); resc=false; \
    { const float dl=rm; mhat=fadd_s(mhat,dl); \
      _Pragma("unroll") for(int r=0;r<16;++r){P0[r]=fsub_s(P0[r],dl);P1[r]=fsub_s(P1[r],dl);} \
      _Pragma("unroll") for(int r=0;r<16;++r)negm[r]=-mhat; asm volatile("":"+v"(negm)); } \
    _Pragma("unroll") for(int r=0;r<16;++r)P0[r]=__builtin_amdgcn_exp2f(P0[r]); }while(0)
  #define RESC() do{ if(resc){ asm volatile("s_waitcnt lgkmcnt(0)":::"memory"); \
      _Pragma("unroll") for(int d_=0;d_<2;++d_) _Pragma("unroll") for(int r=0;r<16;++r)o[d_][r]*=wsf[crow(r,hi)]; } }while(0)
  f32x16 pA0,pA1,pB0,pB1;
  int sl_prev=0,sl_cur=0,sl_next=SLOTB;
  #define ROT() do{sl_prev=sl_cur;sl_cur=sl_next;sl_next=(sl_next==(NSLOT-1)*SLOTB)?0:sl_next+SLOTB;}while(0)
  DMA_K(2,2*SLOTB);
  WAIT_BAR(3);
  qkt(pA0,pA1,Kbase,qr,negm,r32,hi);asm volatile("s_nop 15\n\ts_nop 7":"+v"(pA0),"+v"(pA1));BIAS(pA0,pA1,0);CMASK(pA0,pA1,0);
  START(pA0,pA1);
  _Pragma("unroll") for(int r=0;r<16;++r)pA1[r]=__builtin_amdgcn_exp2f(pA1[r]);
  WAIT_BAR(0);
  DMA_K(3,0);DMA_V(1,SLOTB);
  ROT();
  kload8(kf,kp0+sl_cur);
  WAIT_BAR(2);
  s16x4 vlo[8],vhi[8]; u32x4 pw0,pw1,pw2,pw3;
  #define PKW(P,B) cvtpk_s(P[B],P[B+1])
  #define PAF(k) __builtin_bit_cast(bf16x8,pw##k)
  #define VFR(i) (bf16x8){vlo[i][0],vlo[i][1],vlo[i][2],vlo[i][3],vhi[i][0],vhi[i][1],vhi[i][2],vhi[i][3]}
  #define PIN(x) asm volatile("":"+v"(x))
  #define MX3(a,b,c) __builtin_fmaxf(__builtin_fmaxf((a),(b)),(c))
  #define GAPA(MF,A0,A1,A2,A3,W0,W1,PW) do{ MF; sacc+=A0; sacc+=A1; sacc+=A2; sacc+=A3; PIN(sacc); W0; W1; PIN(PW); SBAR(); }while(0)
  #define EX(v) __builtin_amdgcn_exp2f(v)
  #define GAPB(MF,X,B) do{ MF; X[B]=EX(X[B]); X[B+1]=EX(X[B+1]); X[B+2]=EX(X[B+2]); X[B+3]=EX(X[B+3]); PIN(X); SBAR(); }while(0)
  #define VRD(i) do{ vlo[i]=vtr(vp_+(((i)>>2)*4096+((i)&3)*1024)); vhi[i]=vtr(vp_+(((i)>>2)*4096+((i)&3)*1024+512)); }while(0)
  #define KRD(G,j) do{ if(G){ kload2(kf,kp0+sl_next,j); SBAR(); } }while(0)
  #define STEP(C0,C1,P0,P1,t,GK,GV,GL) do{ SBAR(); \
    const lds_cptr vp_=vp0+sl_prev; \
    VRD(0); SBAR(); float sacc=(P0[0]+P0[1]); \
    GAPA(C0=__builtin_amdgcn_mfma_f32_32x32x16_bf16(kf[0],qr[0],negm,0,0,0), P0[2],P0[3],P0[4],P0[5],     pw0[0]=PKW(P0,0), pw0[1]=PKW(P0,2), pw0); \
    VRD(4); SBAR(); GAPA(C1=__builtin_amdgcn_mfma_f32_32x32x16_bf16(kf[1],qr[0],negm,0,0,0), P0[6],P0[7],P0[8],P0[9],     pw0[2]=PKW(P0,4), pw0[3]=PKW(P0,6), pw0); \
    VRD(1); SBAR(); GAPA(C0=__builtin_amdgcn_mfma_f32_32x32x16_bf16(kf[2],qr[1],C0,0,0,0),   P0[10],P0[11],P0[12],P0[13], pw1[0]=PKW(P0,8), pw1[1]=PKW(P0,10), pw1); \
    VRD(5); SBAR(); GAPA(C1=__builtin_amdgcn_mfma_f32_32x32x16_bf16(kf[3],qr[1],C1,0,0,0),   P0[14],P0[15],P1[0],P1[1],   pw1[2]=PKW(P0,12),pw1[3]=PKW(P0,14), pw1); \
    VRD(2); SBAR(); GAPA(C0=__builtin_amdgcn_mfma_f32_32x32x16_bf16(kf[4],qr[2],C0,0,0,0),   P1[2],P1[3],P1[4],P1[5],     pw2[0]=PKW(P1,0), pw2[1]=PKW(P1,2), pw2); \
    VRD(6); SBAR(); GAPA(C1=__builtin_amdgcn_mfma_f32_32x32x16_bf16(kf[5],qr[2],C1,0,0,0),   P1[6],P1[7],P1[8],P1[9],     pw2[2]=PKW(P1,4), pw2[3]=PKW(P1,6), pw2); \
    VRD(3); SBAR(); GAPA(C0=__builtin_amdgcn_mfma_f32_32x32x16_bf16(kf[6],qr[3],C0,0,0,0),   P1[10],P1[11],P1[12],P1[13], pw3[0]=PKW(P1,8), pw3[1]=PKW(P1,10), pw3); \
    VRD(7); SBAR(); GAPA(C1=__builtin_amdgcn_mfma_f32_32x32x16_bf16(kf[7],qr[3],C1,0,0,0),   P1[14],P1[15],0.f,0.f,       pw3[2]=PKW(P1,12),pw3[3]=PKW(P1,14), pw3); \
    l_reg+=sacc; \
    if(GK){DMA_K((t)+3,sl_cur);} if(GV){DMA_V((t)+1,sl_next);} \
    BIAS(C0,C1,t); CMASK(C0,C1,t); \
    { float a=MX3(C0[0],C0[1],C1[0]),b=MX3(C0[2],C0[3],C1[1]); a=MX3(a,C1[2],C1[3]); \
      _Pragma("unroll") for(int r=4;r<16;r+=4){a=MX3(a,C0[r],C0[r+1]);b=MX3(b,C0[r+2],C0[r+3]);a=MX3(a,C1[r],C1[r+1]);b=MX3(b,C1[r+2],C1[r+3]);} \
      float rm=__builtin_fmaxf(a,b); { auto rr=__builtin_amdgcn_permlane32_swap(__float_as_uint(rm),__float_as_uint(rm),false,false); rm=__builtin_fmaxf(__uint_as_float(rr[0]),__uint_as_float(rr[1])); } \
      resc=false; \
      if(__builtin_expect(__any(rm>(float)THRL),0)){ const float dl=__builtin_fmaxf(rm,0.f); mhat+=dl; \
        _Pragma("unroll") for(int r=0;r<16;++r){C0[r]-=dl;C1[r]-=dl;} \
        _Pragma("unroll") for(int r=0;r<16;++r)negm[r]=-mhat; asm volatile("":"+v"(negm)); \
        const float f=__builtin_amdgcn_exp2f(-dl); l_reg*=f; if(hi==0)wsf[r32]=f; resc=true; } } \
    SBAR(); \
    GAPB(o[0]=__builtin_amdgcn_mfma_f32_32x32x16_bf16(PAF(0),VFR(0),o[0],0,0,0), C0,0); \
    GAPB(o[1]=__builtin_amdgcn_mfma_f32_32x32x16_bf16(PAF(0),VFR(4),o[1],0,0,0), C0,4); \
    KRD(GL,0); GAPB(o[0]=__builtin_amdgcn_mfma_f32_32x32x16_bf16(PAF(1),VFR(1),o[0],0,0,0), C0,8); \
    KRD(GL,1); GAPB(o[1]=__builtin_amdgcn_mfma_f32_32x32x16_bf16(PAF(1),VFR(5),o[1],0,0,0), C0,12); \
    KRD(GL,2); GAPB(o[0]=__builtin_amdgcn_mfma_f32_32x32x16_bf16(PAF(2),VFR(2),o[0],0,0,0), C1,0); \
    KRD(GL,3); GAPB(o[1]=__builtin_amdgcn_mfma_f32_32x32x16_bf16(PAF(2),VFR(6),o[1],0,0,0), C1,4); \
    GAPB(o[0]=__builtin_amdgcn_mfma_f32_32x32x16_bf16(PAF(3),VFR(3),o[0],0,0,0), C1,8); \
    GAPB(o[1]=__builtin_amdgcn_mfma_f32_32x32x16_bf16(PAF(3),VFR(7),o[1],0,0,0), C1,12); \
    }while(0)
  int t=1;
  #undef CMASK
  #define CMASK(P0,P1,t) do{}while(0)
  for(;t+5<NT;t+=2){
    STEP(pB0,pB1,pA0,pA1,t,true,true,true);     WAIT_BAR(2); RESC(); ROT();
    STEP(pA0,pA1,pB0,pB1,t+1,true,true,true);   WAIT_BAR(2); RESC(); ROT();
  }
  #undef CMASK
  #define CMASK(P0,P1,t) do{int jb_=(t)-(NT-4); if(jb_>=0)cmask(P0,P1,jb_,qrel,hi);}while(0)
  #define ENDW(tt) do{ if((tt)+3<NT){WAIT_BAR(2);} else if((tt)+2<NT){WAIT_BAR(1);} else {WAIT_BAR(0);} }while(0)
  for(;t+1<NT;t+=2){
    STEP(pB0,pB1,pA0,pA1,t,(t+3<NT),(t+1<NT),(t+1<NT));       ENDW(t);   RESC(); ROT();
    STEP(pA0,pA1,pB0,pB1,t+1,(t+4<NT),(t+2<NT),(t+2<NT));     ENDW(t+1); RESC(); ROT();
  }
  STEP(pB0,pB1,pA0,pA1,NT-1,false,false,false); RESC();
  { float sacc=pB0[0]+pB0[1]; _Pragma("unroll") for(int r=2;r<16;++r)sacc+=pB0[r]; _Pragma("unroll") for(int r=0;r<16;++r)sacc+=pB1[r]; l_reg+=sacc;
    pw0=(u32x4){PKW(pB0,0),PKW(pB0,2),PKW(pB0,4),PKW(pB0,6)};pw1=(u32x4){PKW(pB0,8),PKW(pB0,10),PKW(pB0,12),PKW(pB0,14)};pw2=(u32x4){PKW(pB1,0),PKW(pB1,2),PKW(pB1,4),PKW(pB1,6)};pw3=(u32x4){PKW(pB1,8),PKW(pB1,10),PKW(pB1,12),PKW(pB1,14)};
    SBAR(); pv(o,vb0+sl_cur,PAF(0),PAF(1),PAF(2),PAF(3)); }
  #undef PKW
  #undef PAF
  #undef VFR
  #undef PIN
  #undef MX3
  #undef GAPA
  #undef GAPB
  #undef EX
  #undef VRD
  #undef KRD
  #undef STEP
  #undef ENDW
  {auto rr=__builtin_amdgcn_permlane32_swap(__float_as_uint(l_reg),__float_as_uint(l_reg),false,false);l_reg=__uint_as_float(rr[0])+__uint_as_float(rr[1]);}
  if(hi==0)wsf[32+r32]=l_reg;asm volatile("s_waitcnt lgkmcnt(0)":::"memory");
  float rli[16];
  #pragma unroll
  for(int r=0;r<16;++r)rli[r]=__builtin_amdgcn_rcpf(wsf[32+crow(r,hi)]);
  bf16*Ow=O+(rowbase+q0+wid*QBLK)*DM+h*D;
  { bf16*stg=(bf16*)(shm+LDS_OST)+wid*2048;
    #pragma unroll
    for(int r=0;r<16;++r){const int orow=crow(r,hi);
      #pragma unroll
      for(int d0=0;d0<2;++d0)stg[orow*64+d0*32+r32]=__float2bfloat16(o[d0][r]*rli[r]);}
    asm volatile("s_waitcnt lgkmcnt(0)":::"memory");
    #pragma unroll
    for(int i=0;i<4;++i){const int row=i*8+(lane>>3),ch=lane&7; const u32x4 v=*(const u32x4*)(stg+row*64+ch*8); ATTN_STORE16(Ow+(long)row*DM+ch*8,v);} }
  asm volatile("s_waitcnt lgkmcnt(0)\n\ts_barrier":::"memory");
  #undef DMA_K
  #undef DMA_V
  #undef CMASK
  #undef BIAS
  #undef START
  #undef RESC
  #undef ROT
}
constexpr int ATTN_LDS_BYTES=LDS_BYTES;
struct AttnTensors { const bf16* Q; const bf16* K; const bf16* V; bf16* O; };
struct AttnUnit { int bh; int qb; };
struct StaticOrder {
  int vcu;
  __device__ __forceinline__ explicit StaticOrder(int grid,int block):vcu((block%8)*(grid/8)+block/8){}
  __device__ __forceinline__ bool next(int i,AttnUnit&u)const{ if(i>=4)return false; const int s=vcu&7; u.bh=vcu>>3; u.qb=(i==0)?s:(i==1)?15-s:(i==2)?16+s:31-s; return true; }
  __device__ __forceinline__ void a_ready(const AttnUnit&)const{}
  __device__ __forceinline__ void done(const AttnUnit&)const{}
};
template<class Sched,int THRL=8> __device__ __forceinline__ void attn_phase(char*lds,const AttnTensors&T,const Sched&S){
  AttnUnit u;
  for(int i=0;S.next(i,u);++i){ S.a_ready(u); attn_unit<THRL>(u.bh/NHEAD,u.bh%NHEAD,u.qb,T.Q,T.K,T.V,T.O,lds); S.done(u); }
}
#undef SBAR
#undef WAIT_BAR
}
#ifndef PG8_SP2
#define PG8_SP2 true
#endif
#ifndef PG8_ALIGN
#define PG8_ALIGN true
#endif
#ifndef EN_PRO
#define EN_PRO 1
#endif
#ifndef EN_GU
#define EN_GU 1
#endif
#ifndef EN_RES
#define EN_RES 1
#endif
#ifndef EN_QKV
#define EN_QKV 1
#endif
#ifndef EN_ATT
#define EN_ATT 1
#endif
#ifndef EN_FIN
#define EN_FIN 1
#endif
#ifndef MK_N_LAUNCHES
#define MK_N_LAUNCHES 1
#endif

constexpr int BATCH = 16, SEQ = 2048, D = 1024, FF = 2816, NH = 16, HD = 64, M = BATCH * SEQ;
constexpr int NQKV_FOX = 3 * D, NQKV_SWA = 1280, NFOX_IN = 3 * D + NH, WIN = 128;
constexpr float C2 = 0.125f * 1.4426950408889634f;
constexpr float L2E = 1.4426950408889634f;
constexpr int NPH = 16;

constexpr size_t MiB = 1u << 20;
constexpr size_t WS_ROWSS = 5 * MiB;
constexpr size_t WS_LFT = 2 * MiB;
constexpr size_t WS_WF = 4 * MiB;
constexpr size_t WS_W = 8 * MiB, FFN_STRIDE = 17 * MiB, WD_OFF = 11 * MiB;
constexpr size_t WS_WFOX = 76 * MiB, WS_WOFOX = 82 * MiB, WS_WSWA = 84 * MiB, WS_WOSWA = 87 * MiB;
constexpr size_t WS_HB = 96 * MiB;
constexpr size_t WS_ACT = 160 * MiB;
constexpr size_t WS_O = WS_ACT + 192 * MiB;
constexpr size_t WS_END = 416 * MiB;

constexpr int LDS_BYTES = 147456;
#define LAS __attribute__((address_space(3)))
typedef unsigned short bf16;
typedef float f32x4 __attribute__((ext_vector_type(4)));
typedef float f32x16 __attribute__((ext_vector_type(16)));
typedef short bf16x8 __attribute__((ext_vector_type(8)));
typedef short s16x4 __attribute__((ext_vector_type(4)));
typedef unsigned u32x4 __attribute__((ext_vector_type(4)));
typedef unsigned u32x2 __attribute__((ext_vector_type(2)));
#define LDS_WAIT() asm volatile("s_waitcnt lgkmcnt(0)" ::: "memory")

__device__ __forceinline__ unsigned pk2(float lo, float hi) { return pg8::cvt_pk_bf16(lo, hi); }
__device__ __forceinline__ float wave_sum(float v) {
#pragma unroll
    for (int o = 1; o < 64; o <<= 1) v += __shfl_xor(v, o);
    return v;
}

#define XB_TMO      128
#define XB_XCNT(j)  (256  + 64 * (j))
#define XB_XSUB(j)  (1280 + 64 * (j))
#define XB_XGEN(j)  (2304 + 64 * (j))
#define XB_TOP      3328
#define XB_TOPGEN   3392
#define XCD_BAR_WORDS 3456
#define XB_SPIN_CAP (1u << 18)

__device__ __forceinline__ unsigned xb_ld(unsigned* p)              { return __hip_atomic_load(p, __ATOMIC_RELAXED, __HIP_MEMORY_SCOPE_AGENT); }
__device__ __forceinline__ unsigned xb_add(unsigned* p, unsigned v) { return __hip_atomic_fetch_add(p, v, __ATOMIC_RELAXED, __HIP_MEMORY_SCOPE_AGENT); }
__device__ __forceinline__ unsigned xb_poll(unsigned* p) { unsigned r; const unsigned z = 0u; asm volatile("global_atomic_add %0, %1, %2, off sc0\n\ts_waitcnt vmcnt(0)" : "=v"(r) : "v"(p), "v"(z) : "memory"); return r; }
__device__ __forceinline__ unsigned xb_xcc_id() { return (unsigned)__builtin_amdgcn_s_getreg((3 << 11) | 20) & 0xFu; }
#define XB_SPIN(cond, bar) do { unsigned _sp = 0; while (cond) { __builtin_amdgcn_s_sleep(1); \
    if ((++_sp & 255u) == 0u) { if (xb_ld(&(bar)[XB_TMO])) break; if (_sp > XB_SPIN_CAP) { atomicAdd(&(bar)[XB_TMO], 1u); break; } } } } while (0)

struct XcdBarrier {
    unsigned* bar; unsigned x; unsigned total;
    volatile LAS unsigned* st;
};

__device__ __forceinline__ XcdBarrier xcd_barrier_post(unsigned* bar, volatile LAS unsigned* st, unsigned total) {
    XcdBarrier b; b.bar = bar; b.x = xb_xcc_id(); b.st = st; b.total = total;
    if (threadIdx.x == 0) (void)xb_add(&bar[XB_XCNT(b.x)], 1u);
    return b;
}
__device__ __forceinline__ void xcd_barrier_complete(unsigned* bar, unsigned x, unsigned& nloc, unsigned& nx, unsigned total) {
    const unsigned G = total;
    unsigned sum, cnt, mine, sp = 0u;
    for (;;) {
        sum = 0u; cnt = 0u; mine = 0u;
#pragma unroll
        for (unsigned j = 0; j < 16; ++j) { const unsigned c = xb_ld(&bar[XB_XCNT(j)]); sum += c; cnt += (c > 0u) ? 1u : 0u; mine = (j == x) ? c : mine; }
        if (sum == G) break;
        __builtin_amdgcn_s_sleep(1);
        if ((++sp & 255u) == 0u) { if (xb_ld(&bar[XB_TMO])) break; if (sp > XB_SPIN_CAP) { atomicAdd(&bar[XB_TMO], 1u); break; } }
    }
    nloc = mine > 0u ? mine : 1u; nx = cnt > 0u ? cnt : 1u;
}

__device__ __forceinline__ void xcd_barrier(const XcdBarrier& b) {
    asm volatile("s_waitcnt vmcnt(0)" ::: "memory");
    __syncthreads();
    if (threadIdx.x == 0) {
        unsigned* bar = b.bar;
        __builtin_amdgcn_s_waitcnt(0);
        unsigned nloc = b.st[0], nx = b.st[1];
        if (nloc == 0u) { xcd_barrier_complete(bar, b.x, nloc, nx, b.total); b.st[0] = nloc; b.st[1] = nx; }
        const unsigned old = xb_add(&bar[XB_XSUB(b.x)], 1u);
        const unsigned gen = old / nloc;
        if (nx == 1u) {
            XB_SPIN(xb_poll(&bar[XB_XSUB(b.x)]) < (gen + 1u) * nloc, bar);
            __builtin_amdgcn_fence(__ATOMIC_ACQUIRE, "agent");
            asm volatile("s_waitcnt vmcnt(0)" ::: "memory");
        } else
        if (old + 1u == (gen + 1u) * nloc) {
            __builtin_amdgcn_fence(__ATOMIC_RELEASE, "agent");
            asm volatile("s_waitcnt vmcnt(0)" ::: "memory");
            const unsigned og = xb_add(&bar[XB_TOP], 1u);
            const unsigned tg = og / nx;
            if (og + 1u == (tg + 1u) * nx) xb_add(&bar[XB_TOPGEN], 1u);
            else XB_SPIN(xb_ld(&bar[XB_TOPGEN]) == tg, bar);
            __builtin_amdgcn_fence(__ATOMIC_ACQUIRE, "agent");
            xb_add(&bar[XB_XGEN(b.x)], 1u);
            asm volatile("s_waitcnt vmcnt(0)" ::: "memory");
        } else {
            XB_SPIN(xb_ld(&bar[XB_XGEN(b.x)]) == gen, bar);
            __builtin_amdgcn_fence(__ATOMIC_ACQUIRE, "agent");
            asm volatile("s_waitcnt vmcnt(0)" ::: "memory");
        }
    }
    __syncthreads();
}

__device__ __forceinline__ void p0_item(const float* W, int Nsrc, int k0, int csrc, int nvalid, const float* gain, bf16* WT, int K, int drow, LAS float* scr, int lane) {
    const int n4 = (lane & 7) * 4, kr = lane >> 3;
    f32x4 v[8]; float gv[8];
#pragma unroll
    for (int i = 0; i < 8; ++i) { const int kk = kr + 8 * i;
        v[i] = (n4 < nvalid) ? *(const f32x4*)(W + (size_t)(k0 + kk) * Nsrc + csrc + n4) : (f32x4){0.f, 0.f, 0.f, 0.f};
        gv[i] = gain ? gain[k0 + kk] : 1.0f; }
#pragma unroll
    for (int i = 0; i < 8; ++i) { const int kk = kr + 8 * i; LAS float* d = scr + kk * 33 + n4; const f32x4 w = v[i] * gv[i]; d[0] = w.x; d[1] = w.y; d[2] = w.z; d[3] = w.w; }
    LDS_WAIT(); asm volatile("" ::: "memory");
    const int c = lane & 7;
#pragma unroll
    for (int j = 0; j < 4; ++j) { const int n = (lane >> 3) + 8 * j; const LAS float* s = scr + (8 * c) * 33 + n;
        u32x4 o; o.x = pk2(s[0 * 33], s[1 * 33]); o.y = pk2(s[2 * 33], s[3 * 33]); o.z = pk2(s[4 * 33], s[5 * 33]); o.w = pk2(s[6 * 33], s[7 * 33]);
        if (n < nvalid) *(u32x4*)(WT + (size_t)(drow + n) * K + k0 + 8 * c) = o; }
    LDS_WAIT(); asm volatile("" ::: "memory");
}

struct Args { const float* in[26]; float* out; unsigned char* ws; int ph_lo, ph_hi; };

__device__ __forceinline__ void p0_prologue(const Args& a, LAS unsigned char* lds, int gw, int NGW, int wave, int lane) {
    LAS float* scr = (LAS float*)(lds + wave * 16384);
    unsigned char* ws = a.ws;
    constexpr int I_G = (D / 64) * (FF / 32), I_D = (FF / 64) * (D / 32), I_FFN = 2 * I_G + I_D;
    constexpr int I_FOX = (D / 64) * (NQKV_FOX / 32), I_F = D / 64, I_O = (D / 64) * (D / 32), I_SWA = (D / 64) * (NQKV_SWA / 32);
    constexpr int NITEMS = 4 * I_FFN + I_FOX + I_F + I_O + I_SWA + I_O;
    for (int it = gw; it < NITEMS; it += NGW) {
        int r = it;
        if (r < 4 * I_FFN) {
            const int f = r / I_FFN; r -= f * I_FFN;
            const int kind = r / I_G; r -= kind * I_G;
            const int ib = f == 0 ? 1 : f == 1 ? 9 : f == 2 ? 13 : 21;
            const float* gain = a.in[ib]; const float* wg = a.in[ib + 1]; const float* wu = a.in[ib + 2]; const float* wd = a.in[ib + 3];
            bf16* Wgu = (bf16*)(ws + WS_W + f * FFN_STRIDE); bf16* Wd = (bf16*)(ws + WS_W + f * FFN_STRIDE + WD_OFF);
            if (kind < 2) { const int nblk = FF / 32, kb = r / nblk, nb = r % nblk, n0 = 32 * nb;
                p0_item(kind == 0 ? wg : wu, FF, 64 * kb, n0, 32, gain, Wgu, D, 256 * (n0 / 128) + 128 * kind + (n0 % 128), scr, lane); }
            else { const int nblk = D / 32, kb = r / nblk, nb = r % nblk; p0_item(wd, D, 64 * kb, 32 * nb, 32, nullptr, Wd, FF, 32 * nb, scr, lane); }
            continue;
        }
        r -= 4 * I_FFN;
        if (r < I_FOX) { const int nblk = NQKV_FOX / 32, kb = r / nblk, nb = r % nblk; p0_item(a.in[6], NFOX_IN, 64 * kb, 32 * nb, 32, a.in[5], (bf16*)(ws + WS_WFOX), D, 32 * nb, scr, lane); continue; }
        r -= I_FOX;
        if (r < I_F) { p0_item(a.in[6], NFOX_IN, 64 * r, NQKV_FOX, 16, a.in[5], (bf16*)(ws + WS_WF), D, 0, scr, lane); continue; }
        r -= I_F;
        if (r < I_O) { const int nblk = D / 32, kb = r / nblk, nb = r % nblk; p0_item(a.in[8], D, 64 * kb, 32 * nb, 32, nullptr, (bf16*)(ws + WS_WOFOX), D, 32 * nb, scr, lane); continue; }
        r -= I_O;
        if (r < I_SWA) { const int nblk = NQKV_SWA / 32, kb = r / nblk, nb = r % nblk; p0_item(a.in[18], NQKV_SWA, 64 * kb, 32 * nb, 32, a.in[17], (bf16*)(ws + WS_WSWA), D, 32 * nb, scr, lane); continue; }
        r -= I_SWA;
        { const int nblk = D / 32, kb = r / nblk, nb = r % nblk; p0_item(a.in[20], D, 64 * kb, 32 * nb, 32, nullptr, (bf16*)(ws + WS_WOSWA), D, 32 * nb, scr, lane); }
    }
    { pg8::rss_t* rs = (pg8::rss_t*)(ws + WS_ROWSS) + M; for (int i = gw * 64 + lane; i < 5 * M; i += NGW * 64) rs[i] = 0ull; }
    { const float* x = a.in[0]; bf16* HB = (bf16*)(ws + WS_HB); pg8::rss_t* rs0 = (pg8::rss_t*)(ws + WS_ROWSS);
      for (int m = 2 * gw; m < M; m += 2 * NGW) { const f32x4* xr = (const f32x4*)(x + (size_t)m * D) + lane; f32x4 v[8]; float s0 = 0.f, s1 = 0.f;
#pragma unroll
          for (int j = 0; j < 8; ++j) v[j] = xr[64 * j];
#pragma unroll
          for (int j = 0; j < 4; ++j) { s0 += (v[j].x * v[j].x + v[j].y * v[j].y) + (v[j].z * v[j].z + v[j].w * v[j].w); s1 += (v[4 + j].x * v[4 + j].x + v[4 + j].y * v[4 + j].y) + (v[4 + j].z * v[4 + j].z + v[4 + j].w * v[4 + j].w); }
          s0 = wave_sum(s0); s1 = wave_sum(s1); if (lane == 0) { rs0[m] = pg8::rss_fix(s0); rs0[m + 1] = pg8::rss_fix(s1); }
          u32x2* o8 = (u32x2*)(HB + (size_t)m * D) + lane;
#pragma unroll
          for (int j = 0; j < 8; ++j) { u32x2 w; w.x = pk2(v[j].x, v[j].y); w.y = pk2(v[j].z, v[j].w); o8[64 * j] = w; } } }
}

__device__ __forceinline__ void fgate(const bf16* HB, const bf16* WF, const pg8::rss_t* rowss, const float* bfg, float* LFT, int gx, int ngrp, int gwl, int NGWL, int lane) {
    const int fr = lane & 15, fq = lane >> 4;
    const int per = (M / 16) / ngrp;
    for (int gi = gwl; gi < per; gi += NGWL) { const int grp = gx * per + gi;
        const int row = grp * 16 + fr;
        const bf16* ap = HB + (size_t)row * D + 8 * fq; const bf16* wp = WF + (size_t)fr * D + 8 * fq;
        f32x4 acc = {0.f, 0.f, 0.f, 0.f};
#pragma unroll 8
        for (int k = 0; k < D; k += 32) { const bf16x8 av = *(const bf16x8*)(ap + k); const bf16x8 wv = *(const bf16x8*)(wp + k); acc = __builtin_amdgcn_mfma_f32_16x16x32_bf16(wv, av, acc, 0, 0, 0); }
        const float rs = pg8::rstd_of(rowss, row); const int b = row / SEQ, s = row % SEQ;
#pragma unroll
        for (int i = 0; i < 4; ++i) { const int j = 4 * fq + i; const float xv = acc[i] * rs + bfg[j];
            const float ls = -(fmaxf(-xv, 0.f) + log1pf(expf(-fabsf(xv))));
            LFT[((size_t)(b * NH + j)) * SEQ + s] = ls; }
    }
}

__device__ __forceinline__ int crow(int r, int hi) { return (r & 3) + 8 * (r >> 2) + 4 * hi; }
#define MFMA32(a, b, c) __builtin_amdgcn_mfma_f32_32x32x16_bf16(a, b, c, 0, 0, 0)
template <int MODE>
__device__ __forceinline__ void attn_cu(LAS unsigned char* lds, const bf16* Qp, int qpitch, const bf16* Kp, const bf16* Vp, int kvpitch, bf16* Op, int opitch, int b, const float* lft_bh, float slope2, float sink2) {
    const int tid = threadIdx.x, lane = tid & 63, wid = tid >> 6, r32 = lane & 31, hi = lane >> 5;
    LAS bf16* Ks = (LAS bf16*)lds;
    LAS bf16* Vt = (LAS bf16*)(lds + 9216);
    LAS float* ctab = (LAS float*)(lds + 18432);
    LAS float* wsum = (LAS float*)(lds + 18432 + 8192);
    const float NEG = -INFINITY;
    if (MODE == 0) {
        __syncthreads();
        f32x4 v = *(const f32x4*)(lft_bh + 4 * tid);
        v.y += v.x; v.z += v.y; v.w += v.z;
        const float tot = v.w; float inc = tot;
#pragma unroll
        for (int o = 1; o < 64; o <<= 1) { const float n = __shfl_up(inc, o); if (lane >= o) inc += n; }
        if (lane == 63) wsum[wid] = inc;
        __syncthreads();
        float off = inc - tot;
        for (int w = 0; w < 8; ++w) { const float ws_ = wsum[w]; if (w < wid) off += ws_; }
        *(LAS f32x4*)(ctab + 4 * tid) = (f32x4){(v.x + off) * L2E, (v.y + off) * L2E, (v.z + off) * L2E, (v.w + off) * L2E};
    }
    for (int qb = 0; qb < SEQ / 256; ++qb) {
        const int q0 = qb * 256, qrow = q0 + wid * 32 + r32;
        const bf16* qptr = Qp + (size_t)(b * SEQ + qrow) * qpitch;
        bf16x8 qr[4];
#pragma unroll
        for (int d0 = 0; d0 < 4; ++d0) qr[d0] = *(const bf16x8*)(qptr + d0 * 16 + hi * 8);
        float m = -1e30f, l = 0.f; f32x16 o0 = {}, o1 = {};
        const int t0 = (MODE == 1) ? (q0 >= WIN ? (q0 - WIN) / 64 : 0) : 0, t1 = (q0 + 256) / 64;
        for (int t = t0; t < t1; ++t) {
            __syncthreads();
            { const int row = tid >> 3, ch = tid & 7; const size_t g = (size_t)(b * SEQ + 64 * t + row) * kvpitch + ch * 8;
              const u32x4 kk = *(const u32x4*)(Kp + g); *(LAS u32x4*)(Ks + row * 72 + ch * 8) = kk;
              const bf16x8 vv = *(const bf16x8*)(Vp + g);
#pragma unroll
              for (int j = 0; j < 8; ++j) Vt[(ch * 8 + j) * 72 + row] = (bf16)vv[j]; }
            __syncthreads();
            f32x16 p0 = {}, p1 = {};
#pragma unroll
            for (int d0 = 0; d0 < 4; ++d0) { const bf16x8 a0 = *(const LAS bf16x8*)(Ks + r32 * 72 + d0 * 16 + hi * 8), a1 = *(const LAS bf16x8*)(Ks + (32 + r32) * 72 + d0 * 16 + hi * 8);
                p0 = MFMA32(a0, qr[d0], p0); p1 = MFMA32(a1, qr[d0], p1); }
            const int kvb = 64 * t + 4 * hi;
#pragma unroll
            for (int r = 0; r < 16; ++r) { const int kvA = kvb + (r & 3) + 8 * (r >> 2), kvB = kvA + 32;
                if (MODE == 0) { p0[r] -= ctab[kvA]; p1[r] -= ctab[kvB]; if (kvA > qrow) p0[r] = NEG; if (kvB > qrow) p1[r] = NEG; }
                else { const int dA = qrow - kvA, dB = qrow - kvB; p0[r] -= slope2 * (float)dA; p1[r] -= slope2 * (float)dB;
                    if (dA < 0 || dA >= WIN) p0[r] = NEG; if (dB < 0 || dB >= WIN) p1[r] = NEG; } }
            float rm = fmaxf(p0[0], p1[0]);
#pragma unroll
            for (int r = 1; r < 16; ++r) rm = fmaxf(rm, fmaxf(p0[r], p1[r]));
            rm = fmaxf(rm, __shfl_xor(rm, 32));
            const float mn = fmaxf(m, rm), alpha = __builtin_amdgcn_exp2f(m - mn); m = mn;
            float s = 0.f;
#pragma unroll
            for (int r = 0; r < 16; ++r) { p0[r] = __builtin_amdgcn_exp2f(p0[r] - mn); p1[r] = __builtin_amdgcn_exp2f(p1[r] - mn); s += p0[r] + p1[r]; }
            l = l * alpha + s;
#pragma unroll
            for (int r = 0; r < 16; ++r) { o0[r] *= alpha; o1[r] *= alpha; }
            u32x4 pw[4];
            pw[0] = (u32x4){pk2(p0[0], p0[1]), pk2(p0[2], p0[3]), pk2(p0[4], p0[5]), pk2(p0[6], p0[7])};
            pw[1] = (u32x4){pk2(p0[8], p0[9]), pk2(p0[10], p0[11]), pk2(p0[12], p0[13]), pk2(p0[14], p0[15])};
            pw[2] = (u32x4){pk2(p1[0], p1[1]), pk2(p1[2], p1[3]), pk2(p1[4], p1[5]), pk2(p1[6], p1[7])};
            pw[3] = (u32x4){pk2(p1[8], p1[9]), pk2(p1[10], p1[11]), pk2(p1[12], p1[13]), pk2(p1[14], p1[15])};
#pragma unroll
            for (int c = 0; c < 4; ++c) { const bf16x8 pf = __builtin_bit_cast(bf16x8, pw[c]);
                { const LAS bf16* vp = Vt + r32 * 72 + 16 * c + 4 * hi; const s16x4 lo = *(const LAS s16x4*)vp, hh = *(const LAS s16x4*)(vp + 8);
                  const bf16x8 vf = {lo[0], lo[1], lo[2], lo[3], hh[0], hh[1], hh[2], hh[3]}; o0 = MFMA32(vf, pf, o0); }
                { const LAS bf16* vp = Vt + (32 + r32) * 72 + 16 * c + 4 * hi; const s16x4 lo = *(const LAS s16x4*)vp, hh = *(const LAS s16x4*)(vp + 8);
                  const bf16x8 vf = {lo[0], lo[1], lo[2], lo[3], hh[0], hh[1], hh[2], hh[3]}; o1 = MFMA32(vf, pf, o1); } }
        }
        l += __shfl_xor(l, 32);
        if (MODE == 1) l += __builtin_amdgcn_exp2f(sink2 - m);
        const float inv = 1.0f / l;
        bf16* optr = Op + (size_t)(b * SEQ + qrow) * opitch;
#pragma unroll
        for (int g = 0; g < 4; ++g) { const int d = 8 * g + 4 * hi;
            u32x2 w0; w0.x = pk2(o0[4 * g] * inv, o0[4 * g + 1] * inv); w0.y = pk2(o0[4 * g + 2] * inv, o0[4 * g + 3] * inv); *(u32x2*)(optr + d) = w0;
            u32x2 w1; w1.x = pk2(o1[4 * g] * inv, o1[4 * g + 1] * inv); w1.y = pk2(o1[4 * g + 2] * inv, o1[4 * g + 3] * inv); *(u32x2*)(optr + 32 + d) = w1; }
    }
    __syncthreads();
}

__device__ __forceinline__ void fox_phase(unsigned char* ldsg, const bf16* Q, const bf16* K, const bf16* V, bf16* O, const float* LFT, int gx, int ngrp, int gj, int gsize) {
    LAS float* ctab = (LAS float*)((LAS unsigned char*)ldsg + attn_body::LDS_CT);
    LAS float* wsum = ctab + SEQ;
    const int per = (BATCH * NH) / ngrp;
    for (int bi = gj; bi < per; bi += gsize) { const int bh = gx * per + bi;
        int tid_ = threadIdx.x; asm volatile("" : "+v"(tid_));
        const int tid = tid_, lane = tid & 63, wid = tid >> 6;
        __syncthreads();
        f32x4 v = *(const f32x4*)(LFT + (size_t)bh * SEQ + 4 * tid);
        v.y += v.x; v.z += v.y; v.w += v.z;
        const float tot = v.w; float inc = tot;
#pragma unroll
        for (int o = 1; o < 64; o <<= 1) { const float n = __shfl_up(inc, o); if (lane >= o) inc += n; }
        if (lane == 63) wsum[wid] = inc;
        __syncthreads();
        float off = inc - tot;
        for (int w = 0; w < 8; ++w) { const float ws_ = wsum[w]; if (w < wid) off += ws_; }
        *(LAS f32x4*)(ctab + 4 * tid) = (f32x4){(v.x + off) * L2E, (v.y + off) * L2E, (v.z + off) * L2E, (v.w + off) * L2E};
        __syncthreads();
        for (int qb = SEQ / 256 - 1; qb >= 0; --qb)
            attn_body::attn_unit<48>(bh / NH, bh % NH, qb, (const attn_body::bf16*)Q, (const attn_body::bf16*)K, (const attn_body::bf16*)V, (attn_body::bf16*)O, (char*)ldsg);
    }
}

__device__ __forceinline__ void swa_phase(LAS unsigned char* lds, const bf16* QKV, bf16* O, const float* sinks, int gx, int ngrp, int gj, int gsize) {
    const int tid = threadIdx.x, lane = tid & 63, wid = tid >> 6, r32 = lane & 31, hi = lane >> 5;
    LAS bf16* Kb = (LAS bf16*)lds;
    LAS bf16* Vt = (LAS bf16*)(lds + 36864);
    const float NEG = -INFINITY;
    const int per = (BATCH * 2 * (SEQ / WIN)) / ngrp;
    for (int ii = gj; ii < per; ii += gsize) { const int item = gx * per + ii;
        const int b = item / 32, kvh = (item >> 4) & 1, blk = item & 15;
        __syncthreads();
#pragma unroll
        for (int pass = 0; pass < 4; ++pass) { const int j = pass * 64 + (tid >> 3), ch = tid & 7, pos = WIN * (blk - 1) + j;
            u32x4 kk = {0u, 0u, 0u, 0u}; bf16x8 vv = {0, 0, 0, 0, 0, 0, 0, 0};
            if (pos >= 0) { const size_t g = (size_t)(b * SEQ + pos) * NQKV_SWA + D + kvh * HD + ch * 8; kk = *(const u32x4*)(QKV + g); vv = *(const bf16x8*)(QKV + g + 2 * HD); }
            *(LAS u32x4*)(Kb + j * 72 + ch * 8) = kk;
#pragma unroll
            for (int jj = 0; jj < 8; ++jj) Vt[(ch * 8 + jj) * 264 + j] = (bf16)vv[jj]; }
        __syncthreads();
        const int h = kvh * 8 + wid;
        const float slope2 = exp2f(-8.0f * (float)(h + 1) / 16.0f) * L2E, sink2 = sinks[h] * L2E;
        for (int i = 0; i < 4; ++i) {
            const int qin = 32 * i + r32, qrow = WIN * blk + qin;
            const bf16* qptr = QKV + (size_t)(b * SEQ + qrow) * NQKV_SWA + h * HD;
            bf16x8 qr[4];
#pragma unroll
            for (int d0 = 0; d0 < 4; ++d0) qr[d0] = *(const bf16x8*)(qptr + d0 * 16 + hi * 8);
            float m = -1e30f, l = 0.f; f32x16 o0 = {}, o1 = {};
            const int jt0 = (i < 2) ? 0 : 1;
            const float lc = -slope2 * (float)(WIN + qin - 4 * hi);
#pragma unroll
            for (int js = 0; js < 3; ++js) { const int jt = jt0 + js;
                if (blk == 0 && jt < 2) continue;
                const float tb = lc + slope2 * (float)(64 * jt);
                f32x16 p0, p1;
#pragma unroll
                for (int r = 0; r < 16; ++r) { const float kr = (float)((r & 3) + 8 * (r >> 2)); p0[r] = __builtin_fmaf(slope2, kr, tb); p1[r] = __builtin_fmaf(slope2, kr + 32.0f, tb); }
#pragma unroll
                for (int d0 = 0; d0 < 4; ++d0) { const bf16x8 a0 = *(const LAS bf16x8*)(Kb + (64 * jt + r32) * 72 + d0 * 16 + hi * 8), a1 = *(const LAS bf16x8*)(Kb + (64 * jt + 32 + r32) * 72 + d0 * 16 + hi * 8);
                    p0 = MFMA32(a0, qr[d0], p0); p1 = MFMA32(a1, qr[d0], p1); }
                if (js != 1) {
                    const int d00 = WIN + qin - (64 * jt + 4 * hi);
#pragma unroll
                    for (int r = 0; r < 16; ++r) { const int kr = (r & 3) + 8 * (r >> 2); const int dA = d00 - kr, dB = dA - 32;
                        if (js == 0) { if (dA >= WIN) p0[r] = NEG; if (dB >= WIN) p1[r] = NEG; }
                        else { if (dA < 0) p0[r] = NEG; if (dB < 0) p1[r] = NEG; } }
                }
                float rm = fmaxf(p0[0], p1[0]);
#pragma unroll
                for (int r = 1; r < 16; ++r) rm = fmaxf(rm, fmaxf(p0[r], p1[r]));
                rm = fmaxf(rm, __shfl_xor(rm, 32));
                const float mn = fmaxf(m, rm), alpha = __builtin_amdgcn_exp2f(m - mn); m = mn;
                float s = 0.f;
#pragma unroll
                for (int r = 0; r < 16; ++r) { p0[r] = __builtin_amdgcn_exp2f(p0[r] - mn); p1[r] = __builtin_amdgcn_exp2f(p1[r] - mn); s += p0[r] + p1[r]; }
                l = l * alpha + s;
#pragma unroll
                for (int r = 0; r < 16; ++r) { o0[r] *= alpha; o1[r] *= alpha; }
                u32x4 pw[4];
                pw[0] = (u32x4){pk2(p0[0], p0[1]), pk2(p0[2], p0[3]), pk2(p0[4], p0[5]), pk2(p0[6], p0[7])};
                pw[1] = (u32x4){pk2(p0[8], p0[9]), pk2(p0[10], p0[11]), pk2(p0[12], p0[13]), pk2(p0[14], p0[15])};
                pw[2] = (u32x4){pk2(p1[0], p1[1]), pk2(p1[2], p1[3]), pk2(p1[4], p1[5]), pk2(p1[6], p1[7])};
                pw[3] = (u32x4){pk2(p1[8], p1[9]), pk2(p1[10], p1[11]), pk2(p1[12], p1[13]), pk2(p1[14], p1[15])};
#pragma unroll
                for (int c = 0; c < 4; ++c) { const bf16x8 pf = __builtin_bit_cast(bf16x8, pw[c]);
                    { const LAS bf16* vp = Vt + r32 * 264 + 64 * jt + 16 * c + 4 * hi; const s16x4 lo = *(const LAS s16x4*)vp, hh = *(const LAS s16x4*)(vp + 8);
                      const bf16x8 vf = {lo[0], lo[1], lo[2], lo[3], hh[0], hh[1], hh[2], hh[3]}; o0 = MFMA32(vf, pf, o0); }
                    { const LAS bf16* vp = Vt + (32 + r32) * 264 + 64 * jt + 16 * c + 4 * hi; const s16x4 lo = *(const LAS s16x4*)vp, hh = *(const LAS s16x4*)(vp + 8);
                      const bf16x8 vf = {lo[0], lo[1], lo[2], lo[3], hh[0], hh[1], hh[2], hh[3]}; o1 = MFMA32(vf, pf, o1); } }
            }
            l += __shfl_xor(l, 32);
            l += __builtin_amdgcn_exp2f(sink2 - m);
            const float inv = 1.0f / l;
            bf16* optr = O + (size_t)(b * SEQ + qrow) * D + h * HD;
#pragma unroll
            for (int g = 0; g < 4; ++g) { const int d = 8 * g + 4 * hi;
                u32x2 w0; w0.x = pk2(o0[4 * g] * inv, o0[4 * g + 1] * inv); w0.y = pk2(o0[4 * g + 2] * inv, o0[4 * g + 3] * inv); *(u32x2*)(optr + d) = w0;
                u32x2 w1; w1.x = pk2(o1[4 * g] * inv, o1[4 * g + 1] * inv); w1.y = pk2(o1[4 * g + 2] * inv, o1[4 * g + 3] * inv); *(u32x2*)(optr + 32 + d) = w1; }
        }
    }
    __syncthreads();
}

enum { K_PRO = 0, K_GU = 1, K_RES = 2, K_QKV = 3, K_ATT = 4, K_FIN = 5 };
__device__ __forceinline__ void group_barrier(unsigned* cnt, unsigned target) {
    asm volatile("s_waitcnt vmcnt(0)" ::: "memory");
    __syncthreads();
    if (threadIdx.x == 0) {
        __builtin_amdgcn_fence(__ATOMIC_RELEASE, "agent");
        asm volatile("s_waitcnt vmcnt(0)" ::: "memory");
        (void)__hip_atomic_fetch_add(cnt, 1u, __ATOMIC_RELAXED, __HIP_MEMORY_SCOPE_AGENT);
        unsigned sp = 0u;
        while (__hip_atomic_load(cnt, __ATOMIC_RELAXED, __HIP_MEMORY_SCOPE_AGENT) < target) { __builtin_amdgcn_s_sleep(1); if (++sp > (1u << 23)) break; }
        __builtin_amdgcn_fence(__ATOMIC_ACQUIRE, "agent");
        asm volatile("s_waitcnt vmcnt(0)" ::: "memory");
    }
    __syncthreads();
}
__device__ __forceinline__ void run_phase(const int ph, const Args& a, LAS unsigned char* lds, unsigned char* ldsg, const bool dummy = false) {
    const int tid = threadIdx.x, lane = tid & 63, wave = __builtin_amdgcn_readfirstlane(tid >> 6);
    const int G = gridDim.x, bx = blockIdx.x;
    const int gw = bx * 8 + wave, NGW = G * 8;
    const int ngrp = (G == 256) ? 8 : 1, gsize = G / ngrp, gx = bx % ngrp, gj = bx / ngrp;
    unsigned char* ws = a.ws;
    pg8::rss_t* RS = (pg8::rss_t*)(ws + WS_ROWSS);
    bf16* HB = (bf16*)(ws + WS_HB);
    const size_t rpg = (size_t)(M / ngrp), RPG = (256 * MiB) / ngrp;
    unsigned char* reg = ws + WS_ACT + (size_t)gx * RPG;
    bf16* ACT = (bf16*)(reg - (size_t)gx * rpg * FF * 2);
    bf16* QX = (bf16*)(reg - (size_t)gx * rpg * D * 2); bf16* KX = QX + rpg * D; bf16* VX = QX + 2 * rpg * D; bf16* OB = QX + 3 * rpg * D;
    bf16* SQKV = (bf16*)(reg - (size_t)gx * rpg * NQKV_SWA * 2);
    {

        int kind, f = 0, rsi = 0, rso = -1, lay = 0; float alpha = 0.5f;
        switch (ph) {
            case 0: kind = K_PRO; break;
            case 1: kind = K_GU; f = 0; rsi = 0; break;
            case 2: kind = K_RES; f = 0; rso = 1; break;
            case 3: kind = K_QKV; lay = 0; rsi = 1; break;
            case 4: kind = K_ATT; lay = 0; break;
            case 5: kind = K_RES; f = 4; rso = 2; alpha = 1.f; break;
            case 6: kind = K_GU; f = 1; rsi = 2; break;
            case 7: kind = K_RES; f = 1; rso = 3; break;
            case 8: kind = K_GU; f = 2; rsi = 3; break;
            case 9: kind = K_RES; f = 2; rso = 4; break;
            case 10: kind = K_QKV; lay = 1; rsi = 4; break;
            case 11: kind = K_ATT; lay = 1; break;
            case 12: kind = K_RES; f = 5; rso = 5; alpha = 1.f; break;
            case 13: kind = K_GU; f = 3; rsi = 5; break;
            case 14: kind = K_RES; f = 3; rso = -1; break;
            default: kind = K_FIN; break;
        }
        if (EN_PRO && kind == K_PRO) {
            p0_prologue(a, lds, gw, NGW, wave, lane);
        } else if (EN_GU && kind == K_GU) {
            pg8::Gemm g{HB, (const bf16*)(ws + WS_W + f * FFN_STRIDE), M, 2 * FF, D}; pg8::StaticOrder S; S.init(M, 2 * FF, G, bx);
            pg8::EpiSwiglu E{ACT, FF, RS + (size_t)rsi * M};
            pg8::gemm_phase<pg8::EpiSwiglu, pg8::StaticOrder, PG8_ALIGN, PG8_SP2>(lds, g, S, E);
        } else if (EN_RES && kind == K_RES) {
            const bf16* A = f < 4 ? ACT : OB; const int K = f < 4 ? FF : D;
            const bf16* W = f < 4 ? (const bf16*)(ws + WS_W + f * FFN_STRIDE + WD_OFF) : f == 4 ? (const bf16*)(ws + WS_WOFOX) : (const bf16*)(ws + WS_WOSWA);
            pg8::Gemm g{A, W, M, D, K}; pg8::StaticOrder S; S.init(M, D, G, bx);
            pg8::EpiResid E{ph == 2 ? a.in[0] : nullptr, HB, nullptr, dummy ? (bf16*)(ws + 416 * MiB) : HB, rso >= 0 ? (dummy ? (pg8::rss_t*)(ws + 480 * MiB) : RS + (size_t)rso * M) : nullptr, alpha};
            pg8::gemm_phase<pg8::EpiResid, pg8::StaticOrder, PG8_ALIGN, PG8_SP2>(lds, g, S, E);
        } else if (EN_QKV && kind == K_QKV) {
            if (lay == 0) fgate(HB, (const bf16*)(ws + WS_WF), RS + (size_t)rsi * M, a.in[7], (float*)(ws + WS_LFT), gx, ngrp, gj * 8 + wave, gsize * 8, lane);
            const int N = lay == 0 ? NQKV_FOX : NQKV_SWA;
            pg8::Gemm g{HB, lay == 0 ? (const bf16*)(ws + WS_WFOX) : (const bf16*)(ws + WS_WSWA), M, N, D}; pg8::StaticOrder S; S.init(M, N, G, bx);
            pg8::EpiScale E{lay == 0 ? QX : SQKV, lay == 0 ? D : NQKV_SWA, RS + (size_t)rsi * M, lay == 0 ? D : 0, rpg * D, 4, C2};
            pg8::gemm_phase<pg8::EpiScale, pg8::StaticOrder, PG8_ALIGN, PG8_SP2>(lds, g, S, E);
        } else if (EN_ATT && kind == K_ATT) {
            if (lay == 0) fox_phase(ldsg, QX, KX, VX, OB, (const float*)(ws + WS_LFT), gx, ngrp, gj, gsize);
            else swa_phase(lds, SQKV, OB, a.in[19], gx, ngrp, gj, gsize);
        } else if (EN_FIN) {
            const float* gfin = a.in[25];
            const int perm_ = M / ngrp;
            for (int mi = 2 * (gj * 8 + wave); mi < perm_; mi += 2 * gsize * 8) { const int m = gx * perm_ + mi;
                const u32x2* hr = (const u32x2*)(HB + (size_t)m * D) + lane; u32x2 hv[8];
#pragma unroll
                for (int j = 0; j < 8; ++j) hv[j] = hr[64 * j];
                f32x4 v[8]; float s0 = 0.f, s1 = 0.f;
#pragma unroll
                for (int j = 0; j < 8; ++j) { v[j] = (f32x4){__uint_as_float(hv[j].x << 16), __uint_as_float(hv[j].x & 0xffff0000u), __uint_as_float(hv[j].y << 16), __uint_as_float(hv[j].y & 0xffff0000u)};
                    const float q = (v[j].x * v[j].x + v[j].y * v[j].y) + (v[j].z * v[j].z + v[j].w * v[j].w); if (j < 4) s0 += q; else s1 += q; }
                const float r0 = __builtin_amdgcn_rsqf(wave_sum(s0) * (1.0f / 1024.0f) + 1e-6f), r1 = __builtin_amdgcn_rsqf(wave_sum(s1) * (1.0f / 1024.0f) + 1e-6f);
                f32x4* xr = (f32x4*)(a.out + (size_t)m * D) + lane;
#pragma unroll
                for (int j = 0; j < 8; ++j) { const f32x4 gg = *((const f32x4*)gfin + lane + 64 * (j & 3)); xr[64 * j] = v[j] * (j < 4 ? r0 : r1) * gg; } }
        }
    }
}
__global__ void __launch_bounds__(512, 2) fwd(Args a) {
    extern __shared__ __attribute__((aligned(16))) unsigned char lds_raw[];
    LAS unsigned char* lds = (LAS unsigned char*)lds_raw;
    cg::grid_group grid = cg::this_grid();
    volatile LAS unsigned* MISC = (volatile LAS unsigned*)(lds + 131072 + 320);
    if (threadIdx.x < 32) MISC[threadIdx.x] = 0u;
    __syncthreads();
    XcdBarrier bar = xcd_barrier_post((unsigned*)a.ws + 4096, MISC + 8, gridDim.x);
    if (a.ph_hi > NPH) grid.sync();
#define GRID_SYNC() xcd_barrier(bar)
    const int ngrp_ = (gridDim.x == 256) ? 8 : 1; const unsigned gsize_ = gridDim.x / ngrp_;
    XcdBarrier gbar = xcd_barrier_post((unsigned*)a.ws + 16384 + 4096 * (blockIdx.x % ngrp_), MISC + 10, gsize_);
#define GROUP_SYNC(k) xcd_barrier(gbar)
#ifndef DUP_PHASE
#define DUP_PHASE -1
#endif
#ifndef DUP_SYNC
#define DUP_SYNC 0
#endif
#define PHASE(k) if (a.ph_lo <= (k) && (k) < a.ph_hi) { run_phase((k), a, lds, lds_raw); if ((k) == DUP_PHASE) { GRID_SYNC(); run_phase((k), a, lds, lds_raw, true); } \
        if ((k) == 0) { for (int i_ = 0; i_ < DUP_SYNC; ++i_) GRID_SYNC(); } if ((k) + 1 < a.ph_hi) { if ((k) == 0 || a.ph_lo != 0) GRID_SYNC(); else GROUP_SYNC(k); } }
    PHASE(0) PHASE(1) PHASE(2) PHASE(3) PHASE(4) PHASE(5) PHASE(6) PHASE(7) PHASE(8) PHASE(9) PHASE(10) PHASE(11) PHASE(12) PHASE(13) PHASE(14) PHASE(15)
#undef PHASE
}

extern "C" void kernel_launch(void* const* d_in, const int* in_sizes, int n_in, void* d_out, int out_size, void* d_ws, size_t ws_size, hipStream_t stream) {
    static int grid = 0;
    if (grid == 0) {
        if (n_in != 26 || in_sizes[0] != M * D || out_size != M * D || ws_size < WS_END) { fprintf(stderr, "kernel_launch: unexpected shapes (n_in %d, in0 %d, out %d, ws %zu); nothing launched\n", n_in, n_in > 0 ? in_sizes[0] : -1, out_size, ws_size); grid = -1; return; }
        int dev = 0, cus = 0, per_cu = 0;
        if (hipGetDevice(&dev) != hipSuccess || hipDeviceGetAttribute(&cus, hipDeviceAttributeMultiprocessorCount, dev) != hipSuccess) { grid = -1; return; }
        if (hipFuncSetAttribute((const void*)fwd, hipFuncAttributeMaxDynamicSharedMemorySize, LDS_BYTES) != hipSuccess) { fprintf(stderr, "kernel_launch: hipFuncSetAttribute failed\n"); grid = -1; return; }
        if (hipOccupancyMaxActiveBlocksPerMultiprocessor(&per_cu, (const void*)fwd, 512, LDS_BYTES) != hipSuccess || per_cu < 1) { fprintf(stderr, "kernel_launch: occupancy query says %d blocks per CU\n", per_cu); per_cu = 1; }
        (void)hipGetLastError();
        grid = cus;
    }
    if (grid < 0) return;
    if (hipMemsetAsync(d_ws, 0, 262144, stream) != hipSuccess) { fprintf(stderr, "kernel_launch: hipMemsetAsync of the barrier words failed\n"); return; }
    Args a{};
    for (int i = 0; i < 26; ++i) a.in[i] = (const float*)d_in[i];
    a.out = (float*)d_out; a.ws = (unsigned char*)d_ws;
#if MK_N_LAUNCHES == 1
    a.ph_lo = 0; a.ph_hi = NPH;
    void* args[] = {&a};
    hipError_t e = hipLaunchCooperativeKernel((const void*)fwd, dim3(grid), dim3(512), args, LDS_BYTES, stream);
    if (e != hipSuccess) fprintf(stderr, "kernel_launch: cooperative launch failed: %s (grid %d)\n", hipGetErrorString(e), grid);
#else
    for (int ph = 0; ph < NPH; ++ph) { a.ph_lo = ph; a.ph_hi = ph + 1; hipLaunchKernelGGL(fwd, dim3(grid), dim3(512), LDS_BYTES, stream, a); }
#endif
}
```
